# Optimizing an MI355X kernel written in HIP

```python
import jax
import jax.numpy as jnp
from jax import lax
import numpy as np

D_MODEL = 1024
BATCH = 4
SEQ = 4096
DEPTH = 4
DEC_BATCH = 8
DEC_SEQ = 32
PAST_LEN = 1024

CHUNK = 64
N_META = 16
WINDOW = 128
WINDOW_CHUNKS = WINDOW // CHUNK
A_HEADS = 8
A_KV_HEADS = 2
A_HEAD_DIM = 64
A_GROUP = A_HEADS // A_KV_HEADS
A_Q_W = A_HEADS * A_HEAD_DIM
A_KV_W = A_KV_HEADS * A_HEAD_DIM
B_HEADS = 4
B_KEY_DIM = 128
B_VAL_DIM = 128
B_QK_W = B_HEADS * B_KEY_DIM
B_V_W = B_HEADS * B_VAL_DIM
B_BLOCK = 16
CONV_WIDTH = 3
D_FF = 2816
FFN_RESIDUAL = 0.5
N_EVEN = (DEPTH + 1) // 2
N_ODD = DEPTH // 2
EVEN_IN_W = A_Q_W + 2 * A_KV_W + 2 * B_QK_W + 2 * B_V_W
EVEN_OUT_W = A_Q_W + B_V_W
EPS = 1e-6
MASK_VALUE = -1e30
LB_FLOOR = 1e-30

kernel_name = 'hybrid_streaming_swa_hgrn2_shortconv_step'


def rms_norm(x, gain):
    xf = x.astype(jnp.float32)
    y = xf * lax.rsqrt(jnp.mean(xf * xf, axis=-1, keepdims=True) + EPS)
    return (y * gain.astype(jnp.float32)).astype(x.dtype)


def swiglu(h, w_gate, w_up, w_down):
    return (jax.nn.silu(h @ w_gate) * (h @ w_up)) @ w_down


def hgrn_lower_bounds(logits):
    p = jax.nn.softmax(logits.astype(jnp.float32), axis=0)
    return jnp.maximum(jnp.cumsum(p, axis=0) - p[0:1], 0.0)


def sink_attention(q, k, v, sink, key_valid):
    scale = A_HEAD_DIM ** -0.5
    s = jnp.einsum('bcqkgd,bcskd->bckgqs', q.astype(jnp.float32), k.astype(jnp.float32)) * scale
    s = jnp.where(key_valid[None, :, None, None, None, :], s, MASK_VALUE)
    sk = sink.astype(jnp.float32).reshape(A_KV_HEADS, A_GROUP)[None, None, :, :, None, None]
    m = jnp.maximum(jnp.max(s, axis=-1, keepdims=True), sk)
    p = jnp.exp(s - m)
    w = p / (jnp.sum(p, axis=-1, keepdims=True) + jnp.exp(sk - m))
    o = jnp.einsum('bckgqs,bcskd->bcqkgd', w, v.astype(jnp.float32))
    return o.astype(q.dtype)


def swa_prompt(q, k, v, sink):
    bsz, length = q.shape[:2]
    pad = (-N_META) % CHUNK
    n_chunks = (length + pad) // CHUNK
    back = WINDOW_CHUNKS * CHUNK
    qb = jnp.pad(q, ((0, 0), (pad, 0), (0, 0), (0, 0))).reshape(
        bsz, n_chunks, CHUNK, A_KV_HEADS, A_GROUP, A_HEAD_DIM)

    def band(a):
        ap = jnp.pad(a, ((0, 0), (pad + back, 0), (0, 0), (0, 0))).reshape(
            bsz, n_chunks + WINDOW_CHUNKS, CHUNK, A_KV_HEADS, A_HEAD_DIM)
        return jnp.concatenate([ap[:, j:j + n_chunks] for j in range(WINDOW_CHUNKS + 1)], axis=2)

    valid = (jnp.arange((n_chunks + WINDOW_CHUNKS) * CHUNK) >= pad + back).reshape(
        n_chunks + WINDOW_CHUNKS, CHUNK)
    valid = jnp.concatenate([valid[j:j + n_chunks] for j in range(WINDOW_CHUNKS + 1)], axis=1)
    o = sink_attention(qb, band(k), band(v), sink, valid)
    return o.reshape(bsz, n_chunks * CHUNK, A_Q_W)[:, pad:]


def hgrn2_blocks(q, k, v, log_f, s0, block):
    bsz, length, heads, dk = q.shape
    dv = v.shape[-1]
    n = length // block
    causal = jnp.tril(jnp.ones((block, block), bool))[None, :, :, None, None]

    def to_blocks(a):
        return jnp.moveaxis(a.reshape(bsz, n, block, heads, a.shape[-1]), 1, 0)

    def step(state, inp):
        qc, kc, vc, gc = inp
        b = jnp.cumsum(gc, axis=1)
        o_inter = jnp.einsum('bthk,bhkv->bthv', qc * jnp.exp(b), state)
        diff = b[:, :, None] - b[:, None, :]
        decay = jnp.where(causal, jnp.exp(jnp.where(causal, diff, 0.0)), 0.0)
        scores = jnp.einsum('bthk,bshk,btshk->bhts', qc, kc, decay)
        o_intra = jnp.einsum('bhts,bshv->bthv', scores, vc)
        b_last = b[:, -1]
        state = jnp.exp(b_last)[..., None] * state + jnp.einsum(
            'bshk,bshv->bhkv', kc * jnp.exp(b_last[:, None] - b), vc)
        return state, o_inter + o_intra

    state, o = lax.scan(step, s0, (to_blocks(q), to_blocks(k), to_blocks(v), to_blocks(log_f)))
    return jnp.moveaxis(o, 0, 1).reshape(bsz, length, heads, dv), state


def even_mixer(h, w_in, w_out, sink, lb, out_gain, cache_k, cache_v, state):
    bsz, length, _ = h.shape
    widths = (A_Q_W, A_KV_W, A_KV_W, B_QK_W, B_QK_W, B_V_W, B_V_W)
    cuts = [int(c) for c in np.cumsum(widths)[:-1]]
    qa, ka, va, qb, fb, ib, gb = jnp.split(h @ w_in, cuts, axis=-1)
    qa = qa.reshape(bsz, length, A_HEADS, A_HEAD_DIM)
    ka = ka.reshape(bsz, length, A_KV_HEADS, A_HEAD_DIM)
    va = va.reshape(bsz, length, A_KV_HEADS, A_HEAD_DIM)
    if cache_k is None:
        oa = swa_prompt(qa, ka, va, sink)
        new_k, new_v = ka[:, -WINDOW:], va[:, -WINDOW:]
        s0 = jnp.zeros((bsz, B_HEADS, B_KEY_DIM, B_VAL_DIM), jnp.float32)
        block = B_BLOCK
    else:
        kk = jnp.concatenate([cache_k.astype(ka.dtype), ka], axis=1)
        vv = jnp.concatenate([cache_v.astype(va.dtype), va], axis=1)
        qq = qa.reshape(bsz, 1, length, A_KV_HEADS, A_GROUP, A_HEAD_DIM)
        oa = sink_attention(qq, kk[:, None], vv[:, None], sink,
                            jnp.ones((1, kk.shape[1]), bool)).reshape(bsz, length, A_Q_W)
        win = cache_k.shape[1]
        new_k, new_v = kk[:, -win:], vv[:, -win:]
        s0 = state.astype(jnp.float32)
        block = length
    fx = fb.astype(jnp.float32).reshape(bsz, length, B_HEADS, B_KEY_DIM)
    lbh = lb.reshape(B_HEADS, B_KEY_DIM)
    log_f = jnp.logaddexp(jax.nn.log_sigmoid(fx),
                          jnp.log(jnp.maximum(lbh, LB_FLOOR)) + jax.nn.log_sigmoid(-fx))
    k_in = (1.0 - lbh) * jax.nn.sigmoid(-fx)
    q_in = jax.nn.silu(qb.astype(jnp.float32)).reshape(bsz, length, B_HEADS, B_KEY_DIM)
    v_in = ib.astype(jnp.float32).reshape(bsz, length, B_HEADS, B_VAL_DIM)
    ob, s_new = hgrn2_blocks(q_in, k_in, v_in, log_f, s0, block)
    ob = rms_norm(ob.astype(h.dtype), out_gain) * jax.nn.silu(gb).reshape(bsz, length, B_HEADS, B_VAL_DIM)
    out = jnp.concatenate([oa, ob.reshape(bsz, length, B_V_W)], axis=-1) @ w_out
    return out, new_k, new_v, s_new.astype(h.dtype)


def odd_mixer(h, w_in, conv_w, w_out, cache):
    bsz, length, d = h.shape
    bg, cg, xv = jnp.split(h @ w_in, 3, axis=-1)
    u = cg * xv
    if cache is None:
        left = jnp.zeros((bsz, CONV_WIDTH - 1, d), u.dtype)
    else:
        left = cache.astype(u.dtype)
    up = jnp.concatenate([left, u], axis=1)
    y = up[:, 0:length] * conv_w[0]
    for j in range(1, CONV_WIDTH):
        y = y + up[:, j:j + length] * conv_w[j]
    return (bg * y) @ w_out, up[:, -(CONV_WIDTH - 1):]


def run_trunk(x, cache_k, cache_v, rec_state, conv_cache, norm_gains, w_ffn_gate, w_ffn_up, w_ffn_down,
              w_in_even, w_out_even, attn_sinks, lower_bounds, hgrn_norm_gain, w_in_odd, conv_w, w_out_odd):
    streaming = cache_k is not None
    new_k, new_v, new_rec, new_conv = [], [], [], []
    for layer in range(DEPTH):
        g = norm_gains[layer]
        x = x + FFN_RESIDUAL * rms_norm(
            swiglu(rms_norm(x, g[0]), w_ffn_gate[layer, 0], w_ffn_up[layer, 0], w_ffn_down[layer, 0]), g[1])
        h = rms_norm(x, g[2])
        j = layer // 2
        if layer % 2 == 0:
            m, k_rows, v_rows, s_new = even_mixer(
                h, w_in_even[j], w_out_even[j], attn_sinks[j], lower_bounds[j], hgrn_norm_gain[j],
                cache_k[j] if streaming else None, cache_v[j] if streaming else None,
                rec_state[j] if streaming else None)
            new_k.append(k_rows)
            new_v.append(v_rows)
            new_rec.append(s_new)
        else:
            m, c_rows = odd_mixer(h, w_in_odd[j], conv_w[j], w_out_odd[j],
                                  conv_cache[j] if streaming else None)
            new_conv.append(c_rows)
        x = x + rms_norm(m, g[3])
        x = x + FFN_RESIDUAL * rms_norm(
            swiglu(rms_norm(x, g[4]), w_ffn_gate[layer, 1], w_ffn_up[layer, 1], w_ffn_down[layer, 1]), g[5])
    return x, jnp.stack(new_k), jnp.stack(new_v), jnp.stack(new_rec), jnp.stack(new_conv)


def setup_inputs(seed: int = 0) -> dict:
    key = jax.random.key(seed)
    ks = jax.random.split(key, 19)
    nrm = lambda k, shape, s: jax.random.normal(k, shape, jnp.float32) * s
    win = min(WINDOW, PAST_LEN)
    return {
        'x_prompt': nrm(ks[0], (BATCH, SEQ, D_MODEL), 1.0),
        'x_sample': nrm(ks[1], (DEC_BATCH, DEC_SEQ, D_MODEL), 1.0),
        'cache_swa_k': nrm(ks[2], (N_EVEN, DEC_BATCH, win, A_KV_HEADS, A_HEAD_DIM), 1.0),
        'cache_swa_v': nrm(ks[3], (N_EVEN, DEC_BATCH, win, A_KV_HEADS, A_HEAD_DIM), 1.0),
        'state_hgrn': nrm(ks[4], (N_EVEN, DEC_BATCH, B_HEADS, B_KEY_DIM, B_VAL_DIM), 0.5),
        'cache_conv': nrm(ks[5], (N_ODD, DEC_BATCH, CONV_WIDTH - 1, D_MODEL), 1.0),
        'meta_tokens': nrm(ks[6], (N_META, D_MODEL), 1.0),
        'norm_gains': 1.0 + nrm(ks[7], (DEPTH, 6, D_MODEL), 0.05),
        'w_ffn_gate': nrm(ks[8], (DEPTH, 2, D_MODEL, D_FF), D_MODEL ** -0.5),
        'w_ffn_up': nrm(ks[9], (DEPTH, 2, D_MODEL, D_FF), D_MODEL ** -0.5),
        'w_ffn_down': nrm(ks[10], (DEPTH, 2, D_FF, D_MODEL), D_FF ** -0.5),
        'w_in_even': nrm(ks[11], (N_EVEN, D_MODEL, EVEN_IN_W), D_MODEL ** -0.5),
        'w_out_even': nrm(ks[12], (N_EVEN, EVEN_OUT_W, D_MODEL), EVEN_OUT_W ** -0.5),
        'attn_sinks': nrm(ks[13], (N_EVEN, A_HEADS), 0.5),
        'hgrn_lb_logits': 1.0 + nrm(ks[14], (N_EVEN, B_HEADS * B_KEY_DIM), 0.1),
        'hgrn_norm_gain': 1.0 + nrm(ks[15], (N_EVEN, B_HEADS, B_VAL_DIM), 0.05),
        'w_in_odd': nrm(ks[16], (N_ODD, D_MODEL, 3 * D_MODEL), D_MODEL ** -0.5),
        'conv_w': nrm(ks[17], (N_ODD, CONV_WIDTH, D_MODEL), CONV_WIDTH ** -0.5),
        'w_out_odd': nrm(ks[18], (N_ODD, D_MODEL, D_MODEL), D_MODEL ** -0.5),
    }


def reference(x_prompt, x_sample, cache_swa_k, cache_swa_v, state_hgrn, cache_conv, meta_tokens, norm_gains,
              w_ffn_gate, w_ffn_up, w_ffn_down, w_in_even, w_out_even, attn_sinks, hgrn_lb_logits,
              hgrn_norm_gain, w_in_odd, conv_w, w_out_odd):
    lower_bounds = hgrn_lower_bounds(hgrn_lb_logits)
    bsz = x_prompt.shape[0]
    meta = jnp.broadcast_to(meta_tokens[None].astype(x_prompt.dtype), (bsz, N_META, D_MODEL))
    xp = jnp.concatenate([meta, x_prompt], axis=1)
    yp, kp, vp, sp, cp = run_trunk(xp, None, None, None, None, norm_gains, w_ffn_gate, w_ffn_up, w_ffn_down,
                                   w_in_even, w_out_even, attn_sinks, lower_bounds, hgrn_norm_gain,
                                   w_in_odd, conv_w, w_out_odd)
    y_prompt = yp[:, N_META:]
    y_sample, ks_, vs_, ss_, cs_ = run_trunk(x_sample, cache_swa_k, cache_swa_v, state_hgrn, cache_conv,
                                             norm_gains, w_ffn_gate, w_ffn_up, w_ffn_down, w_in_even,
                                             w_out_even, attn_sinks, lower_bounds, hgrn_norm_gain,
                                             w_in_odd, conv_w, w_out_odd)
    return (y_prompt, y_sample, kp, vp, sp, cp, ks_, vs_, ss_, cs_)
```

```cpp
#include <hip/hip_runtime.h>
#include <hip/hip_cooperative_groups.h>
#include <cstdio>
namespace cg = cooperative_groups;

#define LAS __attribute__((address_space(3)))
typedef unsigned short bf16_t;
typedef short bf16x8 __attribute__((ext_vector_type(8)));
typedef float f32x4 __attribute__((ext_vector_type(4)));
typedef float f32x2 __attribute__((ext_vector_type(2)));
typedef unsigned u32x4 __attribute__((ext_vector_type(4)));
typedef unsigned u32x2 __attribute__((ext_vector_type(2)));

#define PROBE_DUP 0
#define PNT_D 2
#define PNT_O 2
constexpr int DM = 1024, FF = 2816;
constexpr int ROW_META = 16384, ROW_SAMP = 16448, ROWS = 16704, ROWS_PAD = 16896;
constexpr int QKVW = 2816;
constexpr float EPS = 1e-6f;
constexpr size_t OFF_YP = 0, OFF_YS = 16777216, OFF_KP = 17039360, OFF_VP = 17170432, OFF_HP = 17301504, OFF_CP = 17825792,
                 OFF_KS = 17842176, OFF_VS = 18104320, OFF_HS = 18366464, OFF_CS = 19415040;
constexpr size_t WS_X = 0;
constexpr size_t WS_H = WS_X + (size_t)ROWS_PAD * 1024 * 2;
constexpr size_t WS_ACT = WS_H + (size_t)ROWS_PAD * 1024 * 2;
constexpr size_t WS_CAT = WS_ACT + (size_t)ROWS_PAD * 3072 * 2;
constexpr size_t WS_W = WS_CAT + (size_t)ROWS_PAD * 1024 * 2;
constexpr size_t W_GUA = 0, W_DA = W_GUA + (size_t)5632 * 1024 * 2, W_GUB = W_DA + (size_t)1024 * 2816 * 2, W_DB = W_GUB + (size_t)5632 * 1024 * 2,
                 W_IN = W_DB + (size_t)1024 * 2816 * 2, W_OUT = W_IN + (size_t)3072 * 1024 * 2, W_END = W_OUT + (size_t)1024 * 1024 * 2;
constexpr size_t WS_U = WS_W + 2 * W_END;
constexpr size_t WS_S = WS_U + (size_t)1072 * 16384 * 4;
constexpr size_t WS_DEC = WS_S + (size_t)1072 * 16384 * 2;
constexpr size_t WS_CTL = WS_DEC + (size_t)1072 * 128 * 4;
constexpr size_t CTL_BYTES = 16384;
constexpr size_t WS_RSTD = WS_CTL + CTL_BYTES;
constexpr size_t WS_LB = WS_RSTD + (size_t)ROWS_PAD * 4;
constexpr size_t WS_END = WS_LB + 4096;
constexpr int LDS_MAIN = 131072, LDS_RSTD = LDS_MAIN + 64, LDS_BYTES = LDS_RSTD + 7 * 1024;

struct P { const float* in[19]; float* out; unsigned char* ws; };

__device__ __forceinline__ float bf2f(bf16_t v) { return __uint_as_float(((unsigned)v) << 16); }
__device__ __forceinline__ unsigned pk2(float lo, float hi) { unsigned r; asm volatile("v_cvt_pk_bf16_f32 %0, %1, %2" : "=v"(r) : "v"(lo), "v"(hi)); return r; }
__device__ __forceinline__ bf16_t f2bf(float f) { return (bf16_t)(pk2(f, 0.f) & 0xffffu); }
__device__ __forceinline__ float lo_bf(unsigned w) { return __uint_as_float(w << 16); }
__device__ __forceinline__ float hi_bf(unsigned w) { return __uint_as_float(w & 0xffff0000u); }
__device__ __forceinline__ float silu_f(float x) { return x * __builtin_amdgcn_rcpf(1.0f + __expf(-x)); }
__device__ __forceinline__ float wave_sum(float v) {
#pragma unroll
    for (int o = 1; o < 64; o <<= 1) v += __shfl_xor(v, o);
    return v;
}

__device__ __forceinline__ int otid() { int t = threadIdx.x; asm volatile("" : "+v"(t)); return t; }
__device__ __forceinline__ int obid() { int t = blockIdx.x; asm volatile("" : "+s"(t)); return t; }

namespace pg8 {
#define PG8_LAS __attribute__((address_space(3)))
constexpr int BM = 256, BK = 64, HALF = 128, HTB = HALF * BK * 2, STAGE_BYTES = 8 * HTB, NXCD = 8, WGM = 8;
__host__ __device__ __forceinline__ int lds_byte(int r, int c) { const int st = (r >> 4) * 2 + (c >> 5), rr = r & 15, cc = c & 31, ob = rr * 64 + cc * 2; return st * 1024 + (ob ^ (((ob >> 9) & 1) << 5)); }
__host__ __device__ __forceinline__ void stage_rc(int b, int& R, int& C) { const int st = b / 1024, sb = b % 1024, swz = sb ^ (((sb >> 9) & 1) << 5); R = (st >> 1) * 16 + swz / 64; C = (st & 1) * 32 + (swz % 64) / 2; }
__host__ __device__ __forceinline__ int perm32(int rho) { const int n = rho >> 4, i = rho & 15; return 8 * (i >> 2) + 4 * n + (i & 3); }
struct Unit { int pm, pn, k0, nt, piece; };
struct Gemm { const bf16_t* A; const bf16_t* Bt; int M, N, K; };
struct StaticOrder {
    int nM, nN, nwg, G, c, ntk;
    __device__ void init(int M, int N, int K, int G_, int c_) { nM = M / BM; nN = N / BM; nwg = nM * nN; G = G_; c = c_; ntk = K / BK; }
    __device__ bool next(int i, Unit& u) const {
        const long L = (long)i * G + c; if (L >= nwg) return false;
        u.k0 = 0; u.nt = ntk; u.piece = -1;
        int wgid = (int)L; { const int q = nwg / NXCD, r = nwg % NXCD, xcd = wgid % NXCD, off = wgid / NXCD; wgid = (xcd < r ? xcd * (q + 1) : r * (q + 1) + (xcd - r) * q) + off; }
        const int nig = WGM * nN, gid = wgid / nig, fm = gid * WGM, gsz = (nM - fm) < WGM ? (nM - fm) : WGM;
        const int rem = wgid - gid * nig;
        if (gsz == WGM) { u.pm = fm + (rem & (WGM - 1)); u.pn = rem >> 3; } else { u.pm = fm + rem % gsz; u.pn = rem / gsz; }
        return true;
    }
};
struct TailOrder {
    int G, c, ntk, pnt, ppu, npieces;
    __device__ void init(int K, int G_, int c_, int pnt_) { G = G_; c = c_; ntk = K / BK; pnt = pnt_; ppu = ntk / pnt_; npieces = 8 * ppu; }
    __device__ bool next(int i, Unit& u) const {
        const int L = i * G + c;
        if (L < 256) { const int wgid = (L & 7) * 32 + (L >> 3); u.pm = (wgid >> 5) * 8 + (wgid & 7); u.pn = (wgid & 31) >> 3; u.k0 = 0; u.nt = ntk; u.piece = -1; return true; }
        const int pi = L - 256; if (pi >= npieces) return false;
        const int tu = pi / ppu, pc = pi - tu * ppu; u.pm = 64 + (tu >> 2); u.pn = tu & 3; u.k0 = pc * pnt; u.nt = pnt; u.piece = pc; return true;
    }
};
template <class Epi, class Sched>
__device__ __forceinline__ void gemm_phase(PG8_LAS unsigned char* lds, const Gemm g, const Sched& S, const Epi& E) {
    const int tid = otid(), wid = __builtin_amdgcn_readfirstlane(tid >> 6), lane = tid & 63, wr = wid >> 2, wc = wid & 3, fr = lane & 15, fq = lane >> 4;
    const int K = g.K;
    unsigned voffA[2], voffB[2];
#pragma unroll
    for (int i = 0; i < 2; ++i) { int R, C; stage_rc(tid * 16 + i * 8192, R, C); const int Rb = (R & ~31) + perm32(R & 31);
        voffA[i] = (unsigned)(R * K + C) * 2u; voffB[i] = (unsigned)(Rb * K + C) * 2u; }
    const size_t kstep = (size_t)(BK * 2);
    const size_t hstep = (size_t)HALF * K * 2;
    const size_t tstep = 2 * hstep;
    const unsigned ldsw = (unsigned)wid * 1024u;
    const int aoff = lds_byte(wr * 64 + fr, fq * 8), boff = lds_byte(wc * 32 + fr, fq * 8);
#define PG8_SA(b, h) (((b) * 2 + (h)) * HTB)
#define PG8_SB(b, h) ((4 + (b) * 2 + (h)) * HTB)
#define PG8_STAGE(bufoff, gbase, voff) do { _Pragma("unroll") for (int _i = 0; _i < 2; ++_i) \
        __builtin_amdgcn_global_load_lds((const unsigned*)((const char*)(gbase) + (voff)[_i]), (PG8_LAS unsigned*)(lds + (bufoff) + ldsw + _i * 8192), 16, 0, 0); } while (0)
#define PG8_LDA(dst, b, h) do { _Pragma("unroll") for (int m = 0; m < 4; ++m) _Pragma("unroll") for (int k = 0; k < 2; ++k) dst[m][k] = *(const PG8_LAS bf16x8*)(lds + PG8_SA(b, h) + aoff + m * 2048 + k * 1024); } while (0)
#define PG8_LDB(dst, b, h) do { _Pragma("unroll") for (int n = 0; n < 2; ++n) _Pragma("unroll") for (int k = 0; k < 2; ++k) dst[n][k] = *(const PG8_LAS bf16x8*)(lds + PG8_SB(b, h) + boff + n * 2048 + k * 1024); } while (0)
#define PG8_MMA(ai, bj, At, Bt) do { __builtin_amdgcn_s_setprio(1); _Pragma("unroll") for (int m = 0; m < 4; ++m) _Pragma("unroll") for (int n = 0; n < 2; ++n) _Pragma("unroll") for (int k = 0; k < 2; ++k) \
        acc[ai][bj][m][n] = __builtin_amdgcn_mfma_f32_16x16x32_bf16(Bt[n][k], At[m][k], acc[ai][bj][m][n], 0, 0, 0); __builtin_amdgcn_s_setprio(0); } while (0)
#define PG8_WAIT_V(n) asm volatile("s_waitcnt vmcnt(" #n ")" ::: "memory")
#define PG8_WAIT_L(n) asm volatile("s_waitcnt lgkmcnt(" #n ")" ::: "memory")
#define PG8_BAR __builtin_amdgcn_s_barrier()
#define PG8_SCHED __builtin_amdgcn_sched_barrier(0)
    Unit cur, nxt; int ui = 0;
    if (!S.next(0, cur)) return;
    f32x4 acc[2][2][4][2];
#pragma unroll
    for (int a = 0; a < 2; ++a)
#pragma unroll
        for (int b = 0; b < 2; ++b)
#pragma unroll
            for (int m = 0; m < 4; ++m)
#pragma unroll
                for (int n = 0; n < 2; ++n) acc[a][b][m][n] = (f32x4){0.f, 0.f, 0.f, 0.f};
    bf16x8 At[4][2], B0[2][2], B1[2][2];
    const char* cA = (const char*)g.A + (size_t)cur.pm * tstep + (size_t)cur.k0 * kstep; const char* cB = (const char*)g.Bt + (size_t)cur.pn * tstep + (size_t)cur.k0 * kstep;
    PG8_STAGE(PG8_SB(0, 0), cB, voffB); PG8_STAGE(PG8_SA(0, 0), cA, voffA); PG8_STAGE(PG8_SB(0, 1), cB + hstep, voffB); PG8_STAGE(PG8_SA(0, 1), cA + hstep, voffA);
    if (wr == 1) PG8_BAR;
    PG8_WAIT_V(4); PG8_BAR;
    PG8_STAGE(PG8_SB(1, 0), cB + kstep, voffB); PG8_STAGE(PG8_SA(1, 0), cA + kstep, voffA); PG8_STAGE(PG8_SB(1, 1), cB + hstep + kstep, voffB);
    PG8_WAIT_V(6); PG8_BAR;
    for (;;) {
        const bool has_next = S.next(ui + 1, nxt);
        const char* nA = has_next ? (const char*)g.A + (size_t)nxt.pm * tstep + (size_t)nxt.k0 * kstep : cA; const char* nB = has_next ? (const char*)g.Bt + (size_t)nxt.pn * tstep + (size_t)nxt.k0 * kstep : cB;
        const int nt = cur.nt;
        for (int t = 0; t < nt; t += 2) {
            const bool last = (t == nt - 2);
            const char* a1 = cA + (size_t)(t + 1) * kstep;
            const char* a2 = last ? nA : cA + (size_t)(t + 2) * kstep; const char* b2 = last ? nB : cB + (size_t)(t + 2) * kstep;
            const char* a3 = a2 + kstep; const char* b3 = b2 + kstep;
            PG8_LDB(B0, 0, 0); PG8_SCHED; PG8_LDA(At, 0, 0); PG8_STAGE(PG8_SA(1, 1), a1 + hstep, voffA);
            PG8_WAIT_L(8); PG8_BAR; PG8_WAIT_L(0); PG8_MMA(0, 0, At, B0); PG8_BAR; PG8_SCHED;
            PG8_LDB(B1, 0, 1); PG8_STAGE(PG8_SB(0, 0), b2, voffB);
            PG8_BAR; PG8_WAIT_L(0); PG8_MMA(0, 1, At, B1); PG8_BAR;
            PG8_LDA(At, 0, 1); PG8_STAGE(PG8_SA(0, 0), a2, voffA);
            PG8_BAR; PG8_WAIT_L(0); PG8_MMA(1, 0, At, B0); PG8_BAR; PG8_SCHED;
            PG8_STAGE(PG8_SB(0, 1), b2 + hstep, voffB);
            PG8_WAIT_V(6); PG8_BAR; PG8_MMA(1, 1, At, B1); PG8_BAR;
            PG8_LDB(B0, 1, 0); PG8_SCHED; PG8_LDA(At, 1, 0); PG8_STAGE(PG8_SA(0, 1), a2 + hstep, voffA);
            PG8_WAIT_L(8); PG8_BAR; PG8_WAIT_L(0); PG8_MMA(0, 0, At, B0); PG8_BAR; PG8_SCHED;
            PG8_LDB(B1, 1, 1); PG8_STAGE(PG8_SB(1, 0), b3, voffB);
            PG8_BAR; PG8_WAIT_L(0); PG8_MMA(0, 1, At, B1); PG8_BAR;
            PG8_LDA(At, 1, 1); PG8_STAGE(PG8_SA(1, 0), a3, voffA);
            PG8_BAR; PG8_WAIT_L(0); PG8_MMA(1, 0, At, B0); PG8_BAR; PG8_SCHED;
            PG8_STAGE(PG8_SB(1, 1), b3 + hstep, voffB);
            PG8_WAIT_V(6); PG8_BAR; PG8_MMA(1, 1, At, B1); PG8_BAR;
        }
        E(acc, cur, wr, wc, fr, fq, ui, (const LAS float*)(lds + LDS_RSTD));
        if (!has_next) break;
#pragma unroll
        for (int a = 0; a < 2; ++a)
#pragma unroll
            for (int b = 0; b < 2; ++b)
#pragma unroll
                for (int m = 0; m < 4; ++m)
#pragma unroll
                    for (int n = 0; n < 2; ++n) { f32x4 z; asm volatile("v_pk_mov_b32 %0, 0, 0\n\tv_pk_mov_b32 %1, 0, 0" : "=v"(*(f32x2*)&z), "=v"(*((f32x2*)&z + 1))); acc[a][b][m][n] = z; }
        cur = nxt; cA = nA; cB = nB; ++ui;
    }
    PG8_WAIT_V(0);
    if (wr == 0) PG8_BAR;
    PG8_BAR;
#undef PG8_SA
#undef PG8_SB
#undef PG8_STAGE
#undef PG8_LDA
#undef PG8_LDB
#undef PG8_MMA
#undef PG8_WAIT_V
#undef PG8_WAIT_L
#undef PG8_BAR
#undef PG8_SCHED
}
}

struct EpiPlain {
    bf16_t* O; int ldc;
    __device__ __forceinline__ void operator()(const f32x4 (&acc)[2][2][4][2], const pg8::Unit& u, int wr, int wc, int fr, int fq, int ui, const LAS float* RS) const {
        const int row0 = u.pm * 256 + wr * 64 + fr, col0 = u.pn * 256 + wc * 32 + 8 * fq;
#pragma unroll
        for (int ai = 0; ai < 2; ++ai)
#pragma unroll
            for (int m = 0; m < 4; ++m) { bf16_t* rowp = O + (size_t)(row0 + ai * 128 + m * 16) * ldc + col0; const float rs = RS[ui * 256 + wr * 64 + fr + ai * 128 + m * 16];
#pragma unroll
                for (int bj = 0; bj < 2; ++bj) { const f32x4 v0 = acc[ai][bj][m][0] * rs, v1 = acc[ai][bj][m][1] * rs;
                    u32x4 w; w.x = pk2(v0[0], v0[1]); w.y = pk2(v0[2], v0[3]); w.z = pk2(v1[0], v1[1]); w.w = pk2(v1[2], v1[3]);
                    *(u32x4*)(rowp + bj * 128) = w; } }
    }
};
__device__ __forceinline__ f32x2 silu_pk(f32x2 t) {
    const f32x2 a = t * (-1.44269504f);
    f32x2 e; e.x = __builtin_amdgcn_exp2f(a.x); e.y = __builtin_amdgcn_exp2f(a.y);
    const f32x2 d = e + 1.0f;
    f32x2 r; r.x = __builtin_amdgcn_rcpf(d.x); r.y = __builtin_amdgcn_rcpf(d.y);
    return t * r;
}
struct EpiEvenIn {
    static constexpr bool PERM = true, AFTER_DRAIN = false;
    bf16_t* O; const float* LB;
    __device__ __forceinline__ void operator()(const f32x4 (&acc)[2][2][4][2], const pg8::Unit& u, int wr, int wc, int fr, int fq, int ui, const LAS float* RS) const {
        const int row0 = u.pm * 256 + wr * 64 + fr, col0 = u.pn * 256 + wc * 32 + 8 * fq;
        const int kind = (u.pn == 3 || u.pn == 4 || u.pn >= 9) ? 1 : ((u.pn == 5 || u.pn == 6) ? 2 : 0);
        f32x4 lbv[2][2];
        if (kind == 2) {
#pragma unroll
            for (int bj = 0; bj < 2; ++bj)
#pragma unroll
                for (int n = 0; n < 2; ++n) { const f32x4 t = *(const f32x4*)(LB + (col0 - 1280) + bj * 128 + 4 * n); lbv[bj][n] = (f32x4){fmaxf(t[0], 1e-30f), fmaxf(t[1], 1e-30f), fmaxf(t[2], 1e-30f), fmaxf(t[3], 1e-30f)}; }
        }
#pragma unroll
        for (int ai = 0; ai < 2; ++ai)
#pragma unroll
            for (int m = 0; m < 4; ++m) { bf16_t* rowp = O + (size_t)(row0 + ai * 128 + m * 16) * QKVW + col0; const float rs = RS[ui * 256 + wr * 64 + fr + ai * 128 + m * 16];
#pragma unroll
                for (int bj = 0; bj < 2; ++bj) { f32x4 v[2] = {acc[ai][bj][m][0] * rs, acc[ai][bj][m][1] * rs};
                    if (kind == 1) {
#pragma unroll
                        for (int n = 0; n < 2; ++n) { const f32x2 s0 = silu_pk((f32x2){v[n][0], v[n][1]}), s1 = silu_pk((f32x2){v[n][2], v[n][3]}); v[n] = (f32x4){s0.x, s0.y, s1.x, s1.y}; }
                    } else if (kind == 2) {
#pragma unroll
                        for (int n = 0; n < 2; ++n)
#pragma unroll
                            for (int h2 = 0; h2 < 2; ++h2) { const f32x2 x = (f32x2){v[n][2 * h2], v[n][2 * h2 + 1]}, lb2 = (f32x2){lbv[bj][n][2 * h2], lbv[bj][n][2 * h2 + 1]};
                                const f32x2 a = __builtin_elementwise_abs(x) * (-1.44269504f);
                                f32x2 ex; ex.x = __builtin_amdgcn_exp2f(a.x); ex.y = __builtin_amdgcn_exp2f(a.y);
                                const f32x2 d = ex + 1.0f; f32x2 r; r.x = __builtin_amdgcn_rcpf(d.x); r.y = __builtin_amdgcn_rcpf(d.y);
                                const f32x2 sm = ex * r;
                                f32x2 sp, sn; sp.x = x.x >= 0.f ? r.x : sm.x; sp.y = x.y >= 0.f ? r.y : sm.y; sn.x = x.x >= 0.f ? sm.x : r.x; sn.y = x.y >= 0.f ? sm.y : r.y;
                                const f32x2 f = sp + lb2 * sn;
                                v[n][2 * h2] = __builtin_amdgcn_logf(f.x) * 0.69314718f; v[n][2 * h2 + 1] = __builtin_amdgcn_logf(f.y) * 0.69314718f; }
                    }
                    u32x4 w; w.x = pk2(v[0][0], v[0][1]); w.y = pk2(v[0][2], v[0][3]); w.z = pk2(v[1][0], v[1][1]); w.w = pk2(v[1][2], v[1][3]);
                    *(u32x4*)(rowp + bj * 128) = w; } }
    }
};
struct EpiPlainTail {
    bf16_t* O; float* PT;
    __device__ __forceinline__ void operator()(const f32x4 (&acc)[2][2][4][2], const pg8::Unit& u, int wr, int wc, int fr, int fq, int ui, const LAS float* RS) const {
        const int row0 = u.pm * 256 + wr * 64 + fr, col0 = u.pn * 256 + wc * 32 + 8 * fq;
        if (u.piece < 0) {
#pragma unroll
            for (int ai = 0; ai < 2; ++ai)
#pragma unroll
                for (int m = 0; m < 4; ++m) { bf16_t* rowp = O + (size_t)(row0 + ai * 128 + m * 16) * 1024 + col0;
#pragma unroll
                    for (int bj = 0; bj < 2; ++bj) { const f32x4 v0 = acc[ai][bj][m][0], v1 = acc[ai][bj][m][1];
                        u32x4 w; w.x = pk2(v0[0], v0[1]); w.y = pk2(v0[2], v0[3]); w.z = pk2(v1[0], v1[1]); w.w = pk2(v1[2], v1[3]);
                        *(u32x4*)(rowp + bj * 128) = w; } }
        } else {
            bf16_t* base = (bf16_t*)PT + (size_t)u.piece * 320 * 1024;
#pragma unroll
            for (int ai = 0; ai < 2; ++ai)
#pragma unroll
                for (int m = 0; m < 4; ++m) { const int row = row0 + ai * 128 + m * 16;
                    if (row < ROWS) { bf16_t* rowp = base + (size_t)(row - ROW_META) * 1024 + col0;
#pragma unroll
                        for (int bj = 0; bj < 2; ++bj) { const f32x4 v0 = acc[ai][bj][m][0], v1 = acc[ai][bj][m][1];
                            u32x4 w; w.x = pk2(v0[0], v0[1]); w.y = pk2(v0[2], v0[3]); w.z = pk2(v1[0], v1[1]); w.w = pk2(v1[2], v1[3]);
                            *(u32x4*)(rowp + bj * 128) = w; } } }
        }
    }
};
__device__ __forceinline__ f32x2 swiglu_pk(f32x2 g, f32x2 u, f32x2 crs, f32x2 rs2) {
    const f32x2 a = g * crs;
    f32x2 e; e.x = __builtin_amdgcn_exp2f(a.x); e.y = __builtin_amdgcn_exp2f(a.y);
    const f32x2 d = e + 1.0f;
    f32x2 r; r.x = __builtin_amdgcn_rcpf(d.x); r.y = __builtin_amdgcn_rcpf(d.y);
    return ((g * u) * rs2) * r;
}
struct EpiSwiglu {
    static constexpr bool PERM = true, AFTER_DRAIN = false;
    bf16_t* O; int ldc;
    __device__ __forceinline__ void operator()(const f32x4 (&acc)[2][2][4][2], const pg8::Unit& u, int wr, int wc, int fr, int fq, int ui, const LAS float* RS) const {
        const int row0 = u.pm * 256 + wr * 64 + fr, col0 = u.pn * 128 + wc * 32 + 8 * fq;
#pragma unroll
        for (int ai = 0; ai < 2; ++ai)
#pragma unroll
            for (int m = 0; m < 4; ++m) { bf16_t* rowp = O + (size_t)(row0 + ai * 128 + m * 16) * ldc + col0; const float rs = RS[ui * 256 + wr * 64 + fr + ai * 128 + m * 16];
                const float crs_ = -1.44269504f * rs, rsq_ = rs * rs; const f32x2 crs = (f32x2){crs_, crs_}, rs2 = (f32x2){rsq_, rsq_};
                const f32x4 g0 = acc[ai][0][m][0], g1 = acc[ai][0][m][1], u0 = acc[ai][1][m][0], u1 = acc[ai][1][m][1];
                const f32x2 o0 = swiglu_pk((f32x2){g0[0], g0[1]}, (f32x2){u0[0], u0[1]}, crs, rs2), o1 = swiglu_pk((f32x2){g0[2], g0[3]}, (f32x2){u0[2], u0[3]}, crs, rs2);
                const f32x2 o2 = swiglu_pk((f32x2){g1[0], g1[1]}, (f32x2){u1[0], u1[1]}, crs, rs2), o3 = swiglu_pk((f32x2){g1[2], g1[3]}, (f32x2){u1[2], u1[3]}, crs, rs2);
                u32x4 w; w.x = pk2(o0.x, o0.y); w.y = pk2(o1.x, o1.y); w.z = pk2(o2.x, o2.y); w.w = pk2(o3.x, o3.y);
                *(u32x4*)rowp = w; }
    }
};
struct EpiOddIn {
    bf16_t* U; bf16_t* BG;
    __device__ __forceinline__ void operator()(const f32x4 (&acc)[2][2][4][2], const pg8::Unit& u, int wr, int wc, int fr, int fq, int ui, const LAS float* RS) const {
        const int row0 = u.pm * 256 + wr * 64 + fr;
        if (u.pn < 8) {
            const int col0 = u.pn * 128 + wc * 32 + 8 * fq;
#pragma unroll
            for (int ai = 0; ai < 2; ++ai)
#pragma unroll
                for (int m = 0; m < 4; ++m) { bf16_t* rowp = U + (size_t)(row0 + ai * 128 + m * 16) * 1024 + col0; const float rs = RS[ui * 256 + wr * 64 + fr + ai * 128 + m * 16], rs2 = rs * rs;
                    const f32x4 c0 = acc[ai][0][m][0], x0 = acc[ai][1][m][0], c1 = acc[ai][0][m][1], x1 = acc[ai][1][m][1]; const f32x2 r2 = (f32x2){rs2, rs2};
                    const f32x2 p0 = ((f32x2){c0[0], c0[1]} * (f32x2){x0[0], x0[1]}) * r2, p1 = ((f32x2){c0[2], c0[3]} * (f32x2){x0[2], x0[3]}) * r2;
                    const f32x2 p2 = ((f32x2){c1[0], c1[1]} * (f32x2){x1[0], x1[1]}) * r2, p3 = ((f32x2){c1[2], c1[3]} * (f32x2){x1[2], x1[3]}) * r2;
                    u32x4 w; w.x = pk2(p0.x, p0.y); w.y = pk2(p1.x, p1.y); w.z = pk2(p2.x, p2.y); w.w = pk2(p3.x, p3.y);
                    *(u32x4*)rowp = w; }
        } else {
            const int col0 = (u.pn - 8) * 256 + wc * 32 + 8 * fq;
#pragma unroll
            for (int ai = 0; ai < 2; ++ai)
#pragma unroll
                for (int m = 0; m < 4; ++m) { bf16_t* rowp = BG + (size_t)(row0 + ai * 128 + m * 16) * 1024 + col0; const float rs = RS[ui * 256 + wr * 64 + fr + ai * 128 + m * 16];
#pragma unroll
                    for (int bj = 0; bj < 2; ++bj) { const f32x4 v0 = acc[ai][bj][m][0] * rs, v1 = acc[ai][bj][m][1] * rs;
                        u32x4 w; w.x = pk2(v0[0], v0[1]); w.y = pk2(v0[2], v0[3]); w.z = pk2(v1[0], v1[1]); w.w = pk2(v1[2], v1[3]);
                        *(u32x4*)(rowp + bj * 128) = w; } }
        }
    }
};

__device__ __forceinline__ int dst_row(int mode, int n) {
    if (mode == 0) return n;
    if (mode == 1) return (n >> 7) * 256 + (n & 127);
    if (mode == 2) return (n >> 7) * 256 + 128 + (n & 127);
    if (n < 1024) return 2048 + n;
    if (n < 2048) { const int c = n - 1024; return (c >> 7) * 256 + (c & 127); }
    { const int c = n - 2048; return (c >> 7) * 256 + 128 + (c & 127); }
}
__device__ __forceinline__ void transpose_item(const float* W, int K, int N, bf16_t* WT, int mode, LAS float* scr, int item, int lane, const float* gk = nullptr) {
    const int nblk = N / 32, kb = item / nblk, nb = item % nblk, k0 = 64 * kb, n0 = 32 * nb;
    { const int kr = lane >> 3, c4 = (lane & 7) * 4;
      f32x4 v[8];
#pragma unroll
      for (int i = 0; i < 8; ++i) v[i] = *(const f32x4*)(W + (size_t)(k0 + 8 * i + kr) * N + n0 + c4);
#pragma unroll
      for (int i = 0; i < 8; ++i) { const int kk = 8 * i + kr; f32x4 t = v[i]; if (gk) t *= gk[k0 + kk];
          LAS float* d = scr + kk * 33 + c4; d[0] = t[0]; d[1] = t[1]; d[2] = t[2]; d[3] = t[3]; } }
    asm volatile("s_waitcnt lgkmcnt(0)" ::: "memory");
    const int c = lane & 7; const int r0 = dst_row(mode, n0);
#pragma unroll
    for (int j = 0; j < 4; ++j) { const int n = (lane >> 3) + 8 * j; const LAS float* s = scr + (8 * c) * 33 + n;
        u32x4 o; o.x = pk2(s[0 * 33], s[1 * 33]); o.y = pk2(s[2 * 33], s[3 * 33]); o.z = pk2(s[4 * 33], s[5 * 33]); o.w = pk2(s[6 * 33], s[7 * 33]);
        *(u32x4*)(WT + (size_t)(r0 + n) * K + k0 + 8 * c) = o; }
    asm volatile("s_waitcnt lgkmcnt(0)" ::: "memory");
}
__device__ __forceinline__ void convert_weights(const P& p, int l, LAS unsigned char* lds, int it0, int it1, int wg, int NW) {
    const int tid_ = otid(); const int lane = tid_ & 63, wave = tid_ >> 6;
    LAS float* scr = (LAS float*)(lds + wave * 8704);
    const int gw = wg * 8 + wave, NGW = NW * 8;
    unsigned char* wb = p.ws + WS_W + (size_t)(l & 1) * W_END; const int j = l >> 1; const bool odd = l & 1;
    constexpr int I_GU = 16 * 88, I_D = 44 * 32, I_OUT = 16 * 32;
    const int I_IN = odd ? 16 * 96 : 16 * 88;
    const int NIT = 6 * I_GU + I_IN + I_OUT;
    if (it1 > NIT) it1 = NIT;
    const size_t gsz = (size_t)1024 * 2816;
    const float* ga = p.in[7] + (size_t)(l * 6 + 0) * DM; const float* gm = p.in[7] + (size_t)(l * 6 + 2) * DM; const float* gb = p.in[7] + (size_t)(l * 6 + 4) * DM;
    for (int it = it0 + gw; it < it1; it += NGW) {
        int r = it;
        if (r < I_GU) { transpose_item(p.in[8] + (size_t)(l * 2 + 0) * gsz, 1024, 2816, (bf16_t*)(wb + W_GUA), 1, scr, r, lane, ga); continue; } r -= I_GU;
        if (r < I_GU) { transpose_item(p.in[9] + (size_t)(l * 2 + 0) * gsz, 1024, 2816, (bf16_t*)(wb + W_GUA), 2, scr, r, lane, ga); continue; } r -= I_GU;
        if (r < I_D) { transpose_item(p.in[10] + (size_t)(l * 2 + 0) * gsz, 2816, 1024, (bf16_t*)(wb + W_DA), 0, scr, r, lane); continue; } r -= I_D;
        if (r < I_GU) { transpose_item(p.in[8] + (size_t)(l * 2 + 1) * gsz, 1024, 2816, (bf16_t*)(wb + W_GUB), 1, scr, r, lane, gb); continue; } r -= I_GU;
        if (r < I_GU) { transpose_item(p.in[9] + (size_t)(l * 2 + 1) * gsz, 1024, 2816, (bf16_t*)(wb + W_GUB), 2, scr, r, lane, gb); continue; } r -= I_GU;
        if (r < I_D) { transpose_item(p.in[10] + (size_t)(l * 2 + 1) * gsz, 2816, 1024, (bf16_t*)(wb + W_DB), 0, scr, r, lane); continue; } r -= I_D;
        if (r < I_IN) {
            if (odd) transpose_item(p.in[16] + (size_t)j * 1024 * 3072, 1024, 3072, (bf16_t*)(wb + W_IN), 3, scr, r, lane, gm);
            else transpose_item(p.in[11] + (size_t)j * 1024 * 2816, 1024, 2816, (bf16_t*)(wb + W_IN), 0, scr, r, lane, gm);
            continue; } r -= I_IN;
        transpose_item((odd ? p.in[18] : p.in[12]) + (size_t)j * 1024 * 1024, 1024, 1024, (bf16_t*)(wb + W_OUT), 0, scr, r, lane);
    }
}

template <int MODE, int NPART>
__device__ __forceinline__ void norm_phase(const P& p, const float* gA, const float* gB, float alpha) {
    const int tid_ = otid(); const int lane = tid_ & 63, wave = tid_ >> 6;
    const int gw = obid() * 8 + wave;
    bf16_t* X = (bf16_t*)(p.ws + WS_X); bf16_t* H = (bf16_t*)(p.ws + WS_H);
    if (MODE == 0 && gw < ROWS_PAD - ROWS) {
        const int row = ROWS + gw; bf16_t* C0 = (bf16_t*)(p.ws + WS_CAT);
#pragma unroll
        for (int jj = 0; jj < 4; ++jj) { *(u32x2*)(X + (size_t)row * DM + lane * 4 + 256 * jj) = (u32x2){0u, 0u}; *(u32x2*)(C0 + (size_t)row * DM + lane * 4 + 256 * jj) = (u32x2){0u, 0u}; }
        if (lane == 0) ((float*)(p.ws + WS_RSTD))[row] = 0.f;
    }
    for (int it = 0; it < 9; ++it) {
        int row;
        if (MODE == 0) row = gw + it * 2048;
        else if (it < 7) row = gw + 2048 * it;
        else if (it == 7) row = gw < 320 ? ROW_META + gw : gw + 2048 * 7;
        else row = (gw >= 320 && gw < 640) ? 14336 + (gw - 320) : ROWS;
        if (row >= ROWS) break;
        f32x4 x[4];
        if (MODE == 0) { const float* xsrc = row < ROW_META ? p.in[0] + (size_t)row * DM : (row < ROW_SAMP ? p.in[6] + (size_t)((row - ROW_META) & 15) * DM : p.in[1] + (size_t)(row - ROW_SAMP) * DM);
#pragma unroll
            for (int jj = 0; jj < 4; ++jj) x[jj] = *(const f32x4*)(xsrc + lane * 4 + 256 * jj); }
        else {
#pragma unroll
            for (int jj = 0; jj < 4; ++jj) { const u32x2 w = *(const u32x2*)(X + (size_t)row * DM + lane * 4 + 256 * jj); x[jj] = (f32x4){lo_bf(w.x), hi_bf(w.x), lo_bf(w.y), hi_bf(w.y)}; } }
        if (MODE != 0) {
            f32x4 y[4]; float ss = 0.f;
            if (row < ROW_META) {
#pragma unroll
                for (int jj = 0; jj < 4; ++jj) { const u32x2 w = *(const u32x2*)(H + (size_t)row * DM + lane * 4 + 256 * jj);
                    y[jj] = (f32x4){lo_bf(w.x), hi_bf(w.x), lo_bf(w.y), hi_bf(w.y)}; }
            } else {
                const bf16_t* pt = (const bf16_t*)(p.ws + WS_U) + (size_t)(row - ROW_META) * DM + lane * 4;
#pragma unroll
                for (int jj = 0; jj < 4; ++jj) y[jj] = (f32x4){0.f, 0.f, 0.f, 0.f};
                u32x2 part[NPART > 0 ? NPART : 1][4];
#pragma unroll
                for (int pc = 0; pc < NPART; ++pc)
#pragma unroll
                    for (int jj = 0; jj < 4; ++jj) part[pc][jj] = *(const u32x2*)(pt + (size_t)pc * 320 * 1024 + 256 * jj);
#pragma unroll
                for (int pc = 0; pc < NPART; ++pc)
#pragma unroll
                    for (int jj = 0; jj < 4; ++jj) y[jj] += (f32x4){lo_bf(part[pc][jj].x), hi_bf(part[pc][jj].x), lo_bf(part[pc][jj].y), hi_bf(part[pc][jj].y)};
            }
#pragma unroll
            for (int jj = 0; jj < 4; ++jj) ss += (y[jj][0] * y[jj][0] + y[jj][1] * y[jj][1]) + (y[jj][2] * y[jj][2] + y[jj][3] * y[jj][3]);
            const float rs = alpha * __builtin_amdgcn_rsqf(wave_sum(ss) * (1.0f / DM) + EPS);
#pragma unroll
            for (int jj = 0; jj < 4; ++jj) { const f32x4 g = *(const f32x4*)(gA + lane * 4 + 256 * jj); x[jj] += y[jj] * g * rs; }
        }
        if (MODE == 2) {
            float* o = row < ROW_META ? p.out + OFF_YP + (size_t)row * DM : (row >= ROW_SAMP ? p.out + OFF_YS + (size_t)(row - ROW_SAMP) * DM : nullptr);
            if (o) {
#pragma unroll
                for (int jj = 0; jj < 4; ++jj) *(f32x4*)(o + lane * 4 + 256 * jj) = x[jj];
            }
        } else {
            float ss = 0.f;
#pragma unroll
            for (int jj = 0; jj < 4; ++jj) { u32x2 xw; xw.x = pk2(x[jj][0], x[jj][1]); xw.y = pk2(x[jj][2], x[jj][3]); *(u32x2*)(X + (size_t)row * DM + lane * 4 + 256 * jj) = xw;
                ss += (x[jj][0] * x[jj][0] + x[jj][1] * x[jj][1]) + (x[jj][2] * x[jj][2] + x[jj][3] * x[jj][3]); }
            const float rs = __builtin_amdgcn_rsqf(wave_sum(ss) * (1.0f / DM) + EPS);
            if (lane == 0) ((float*)(p.ws + WS_RSTD))[row] = rs;
        }
    }
}

__device__ __forceinline__ void conv_phase(const P& p, int j) {
    const int tid_ = otid(); const int lane = tid_ & 63, wave = tid_ >> 6;
    const int gw = obid() * 8 + wave, NGW = gridDim.x * 8;
    const bf16_t* U = (const bf16_t*)(p.ws + WS_ACT); const bf16_t* BG = U + (size_t)ROWS_PAD * 1024; bf16_t* CAT = (bf16_t*)(p.ws + WS_CAT);
    const float* cw = p.in[17] + (size_t)j * 3 * DM; const float* cache = p.in[5] + (size_t)j * 8 * 2 * DM;
    for (int row = gw; row < ROWS; row += NGW) {
        int r1 = -1, r2 = -1; const float* c1 = nullptr; const float* c2 = nullptr; float* so = nullptr;
        if (row < ROW_META) { const int b = row >> 12, t = row & 4095;
            r1 = t >= 1 ? row - 1 : ROW_META + b * 16 + 15; r2 = t >= 2 ? row - 2 : ROW_META + b * 16 + 14 + t;
            if (t >= 4094) so = p.out + OFF_CP + (size_t)((j * 4 + b) * 2 + (t - 4094)) * DM;
        } else if (row < ROW_SAMP) { const int i = (row - ROW_META) & 15; if (i >= 1) r1 = row - 1; if (i >= 2) r2 = row - 2; }
        else { const int b = (row - ROW_SAMP) >> 5, t = (row - ROW_SAMP) & 31;
            if (t >= 1) r1 = row - 1; else c1 = cache + (size_t)(b * 2 + 1) * DM;
            if (t >= 2) r2 = row - 2; else c2 = cache + (size_t)(b * 2 + t) * DM;
            if (t >= 30) so = p.out + OFF_CS + (size_t)((j * 8 + b) * 2 + (t - 30)) * DM; }
#pragma unroll
        for (int jj = 0; jj < 4; ++jj) { const int col = lane * 4 + 256 * jj;
            const u32x2 wu = *(const u32x2*)(U + (size_t)row * DM + col), wb = *(const u32x2*)(BG + (size_t)row * DM + col);
            const f32x4 u0 = (f32x4){lo_bf(wu.x), hi_bf(wu.x), lo_bf(wu.y), hi_bf(wu.y)}, bg = (f32x4){lo_bf(wb.x), hi_bf(wb.x), lo_bf(wb.y), hi_bf(wb.y)};
            f32x4 u1 = (f32x4){0.f, 0.f, 0.f, 0.f}, u2 = u1;
            if (r1 >= 0) { const u32x2 w = *(const u32x2*)(U + (size_t)r1 * DM + col); u1 = (f32x4){lo_bf(w.x), hi_bf(w.x), lo_bf(w.y), hi_bf(w.y)}; } else if (c1) u1 = *(const f32x4*)(c1 + col);
            if (r2 >= 0) { const u32x2 w = *(const u32x2*)(U + (size_t)r2 * DM + col); u2 = (f32x4){lo_bf(w.x), hi_bf(w.x), lo_bf(w.y), hi_bf(w.y)}; } else if (c2) u2 = *(const f32x4*)(c2 + col);
            const f32x4 w0 = *(const f32x4*)(cw + col), w1 = *(const f32x4*)(cw + DM + col), w2 = *(const f32x4*)(cw + 2 * DM + col);
            const f32x4 y = bg * (u2 * w0 + u1 * w1 + u0 * w2);
            u32x2 o; o.x = pk2(y[0], y[1]); o.y = pk2(y[2], y[3]); *(u32x2*)(CAT + (size_t)row * DM + col) = o;
            if (so) *(f32x4*)(so + col) = u0; }
    }
}

__device__ __forceinline__ void att_item(const P& p, int j, int item, LAS unsigned char* lds) {
    const int tid = otid(), lane = tid & 63, w = tid >> 6, fr = lane & 15, fq = lane >> 4;
    const bf16_t* QKV = (const bf16_t*)(p.ws + WS_ACT); bf16_t* CAT = (bf16_t*)(p.ws + WS_CAT);
    LAS bf16_t* Ks = (LAS bf16_t*)lds;
    LAS bf16_t* Vt = (LAS bf16_t*)(lds + 27648);
    const bool samp = item >= 520;
    int b, c, kv, nq, nkeys, qrow0;
    if (!samp) { kv = item & 1; const int bc = item >> 1; c = bc % 65; b = bc / 65; nq = c ? 64 : 16; qrow0 = c ? b * 4096 + (c - 1) * 64 : ROW_META + b * 16; nkeys = c >= 3 ? 192 : 16 + 64 * c; }
    else { const int s = item - 520; kv = s & 1; b = s >> 1; c = 0; nq = 32; qrow0 = ROW_SAMP + b * 32; nkeys = 160; }
    __syncthreads();
    for (int idx = tid; idx < 192 * 8; idx += 512) {
        const int s = idx >> 3, d0 = (idx & 7) * 8;
        f32x4 ka = (f32x4){0.f, 0.f, 0.f, 0.f}, kb = ka, va = ka, vb = ka;
        if (s < nkeys) {
            if (samp && s < 128) {
                const size_t o = ((size_t)((j * 8 + b) * 128 + s) * 2 + kv) * 64 + d0;
                ka = *(const f32x4*)(p.in[2] + o); kb = *(const f32x4*)(p.in[2] + o + 4); va = *(const f32x4*)(p.in[3] + o); vb = *(const f32x4*)(p.in[3] + o + 4);
            } else {
                int row;
                if (samp) row = ROW_SAMP + b * 32 + (s - 128);
                else if (c >= 3) row = b * 4096 + (c - 3) * 64 + s;
                else row = s < 16 ? ROW_META + b * 16 + s : b * 4096 + (s - 16);
                const u32x4 kq = *(const u32x4*)(QKV + (size_t)row * QKVW + 512 + kv * 64 + d0), vq = *(const u32x4*)(QKV + (size_t)row * QKVW + 640 + kv * 64 + d0);
                ka = (f32x4){lo_bf(kq.x), hi_bf(kq.x), lo_bf(kq.y), hi_bf(kq.y)}; kb = (f32x4){lo_bf(kq.z), hi_bf(kq.z), lo_bf(kq.w), hi_bf(kq.w)};
                va = (f32x4){lo_bf(vq.x), hi_bf(vq.x), lo_bf(vq.y), hi_bf(vq.y)}; vb = (f32x4){lo_bf(vq.z), hi_bf(vq.z), lo_bf(vq.w), hi_bf(vq.w)};
            }
            float* ok = nullptr; float* ov = nullptr;
            if (samp) { if (s >= 32) { const size_t o = ((size_t)((j * 8 + b) * 128 + (s - 32)) * 2 + kv) * 64 + d0; ok = p.out + OFF_KS + o; ov = p.out + OFF_VS + o; } }
            else if (c >= 63 && s >= 128) { const size_t o = ((size_t)((j * 4 + b) * 128 + (c - 63) * 64 + (s - 128)) * 2 + kv) * 64 + d0; ok = p.out + OFF_KP + o; ov = p.out + OFF_VP + o; }
            if (ok) { *(f32x4*)ok = ka; *(f32x4*)(ok + 4) = kb; *(f32x4*)ov = va; *(f32x4*)(ov + 4) = vb; }
        }
        u32x4 kw; kw.x = pk2(ka[0], ka[1]); kw.y = pk2(ka[2], ka[3]); kw.z = pk2(kb[0], kb[1]); kw.w = pk2(kb[2], kb[3]);
        *(LAS u32x4*)(Ks + s * 72 + d0) = kw;
        const unsigned v0 = pk2(va[0], va[1]), v1 = pk2(va[2], va[3]), v2 = pk2(vb[0], vb[1]), v3 = pk2(vb[2], vb[3]);
        Vt[(d0 + 0) * 200 + s] = (bf16_t)(v0 & 0xffffu); Vt[(d0 + 1) * 200 + s] = (bf16_t)(v0 >> 16);
        Vt[(d0 + 2) * 200 + s] = (bf16_t)(v1 & 0xffffu); Vt[(d0 + 3) * 200 + s] = (bf16_t)(v1 >> 16);
        Vt[(d0 + 4) * 200 + s] = (bf16_t)(v2 & 0xffffu); Vt[(d0 + 5) * 200 + s] = (bf16_t)(v2 >> 16);
        Vt[(d0 + 6) * 200 + s] = (bf16_t)(v3 & 0xffffu); Vt[(d0 + 7) * 200 + s] = (bf16_t)(v3 >> 16);
    }
    __syncthreads();
    const int nqt = nq >> 4, ntile = 4 * nqt, nkt = nkeys >> 4;
    for (int tt = w; tt < ntile; tt += 8) {
        const int g = tt / nqt, ttile = tt - g * nqt, hd = kv * 4 + g;
        const int row = qrow0 + ttile * 16 + fr;
        const bf16x8 qf0 = *(const bf16x8*)(QKV + (size_t)row * QKVW + hd * 64 + fq * 8), qf1 = *(const bf16x8*)(QKV + (size_t)row * QKVW + hd * 64 + 32 + fq * 8);
        const float sink = p.in[13][j * 8 + hd];
        f32x4 sc[12];
#pragma unroll
        for (int kt = 0; kt < 12; ++kt) {
            if (kt < nkt) {
                const bf16x8 k0 = *(const LAS bf16x8*)(Ks + (kt * 16 + fr) * 72 + fq * 8), k1 = *(const LAS bf16x8*)(Ks + (kt * 16 + fr) * 72 + 32 + fq * 8);
                f32x4 a = (f32x4){0.f, 0.f, 0.f, 0.f};
                a = __builtin_amdgcn_mfma_f32_16x16x32_bf16(k0, qf0, a, 0, 0, 0); a = __builtin_amdgcn_mfma_f32_16x16x32_bf16(k1, qf1, a, 0, 0, 0);
                sc[kt] = a * 0.125f;
            } else sc[kt] = (f32x4){-1e30f, -1e30f, -1e30f, -1e30f};
        }
        float mx = sink;
#pragma unroll
        for (int kt = 0; kt < 12; ++kt) mx = fmaxf(mx, fmaxf(fmaxf(sc[kt][0], sc[kt][1]), fmaxf(sc[kt][2], sc[kt][3])));
        mx = fmaxf(mx, __shfl_xor(mx, 16)); mx = fmaxf(mx, __shfl_xor(mx, 32));
        float sum = 0.f;
#pragma unroll
        for (int kt = 0; kt < 12; ++kt) {
#pragma unroll
            for (int r = 0; r < 4; ++r) { const float e = __expf(sc[kt][r] - mx); sc[kt][r] = e; sum += e; } }
        sum += __shfl_xor(sum, 16); sum += __shfl_xor(sum, 32);
        sum += __expf(sink - mx);
        const float inv = 1.0f / sum;
        f32x4 o[4];
#pragma unroll
        for (int dt = 0; dt < 4; ++dt) o[dt] = (f32x4){0.f, 0.f, 0.f, 0.f};
#pragma unroll
        for (int jj = 0; jj < 6; ++jj) {
            if (2 * jj < nkt) {
                u32x4 pw; pw.x = pk2(sc[2 * jj][0], sc[2 * jj][1]); pw.y = pk2(sc[2 * jj][2], sc[2 * jj][3]); pw.z = pk2(sc[2 * jj + 1][0], sc[2 * jj + 1][1]); pw.w = pk2(sc[2 * jj + 1][2], sc[2 * jj + 1][3]);
                const bf16x8 pf = __builtin_bit_cast(bf16x8, pw);
#pragma unroll
                for (int dt = 0; dt < 4; ++dt) {
                    const u32x2 lo = *(const LAS u32x2*)(Vt + (dt * 16 + fr) * 200 + 32 * jj + 4 * fq), hi = *(const LAS u32x2*)(Vt + (dt * 16 + fr) * 200 + 32 * jj + 16 + 4 * fq);
                    u32x4 vw; vw.x = lo.x; vw.y = lo.y; vw.z = hi.x; vw.w = hi.y;
                    o[dt] = __builtin_amdgcn_mfma_f32_16x16x32_bf16(__builtin_bit_cast(bf16x8, vw), pf, o[dt], 0, 0, 0);
                }
            }
        }
        bf16_t* orow = CAT + (size_t)row * DM + hd * 64 + 4 * fq;
#pragma unroll
        for (int dt = 0; dt < 4; ++dt) { u32x2 ow; ow.x = pk2(o[dt][0] * inv, o[dt][1] * inv); ow.y = pk2(o[dt][2] * inv, o[dt][3] * inv); *(u32x2*)(orow + dt * 16) = ow; }
    }
}

__device__ __forceinline__ void hgrn_gates(const bf16_t* QKV, int row0, int ntok, int h, int tq, int k, float (&cs)[16], float (&kin)[16]) {
    const bool valid = tq * 16 < ntok;
    float run = 0.f;
    if (!valid) {
#pragma unroll
        for (int i = 0; i < 16; ++i) { cs[i] = 0.f; kin[i] = 0.f; }
        return;
    }
    const bf16_t* src = QKV + (size_t)(row0 + tq * 16) * QKVW + 1280 + h * 128 + k;
    bf16_t raw[16];
#pragma unroll
    for (int i = 0; i < 16; ++i) raw[i] = src[(size_t)i * QKVW];
#pragma unroll
    for (int i = 0; i < 16; ++i) { const float lf = bf2f(raw[i]); run += lf; cs[i] = run; kin[i] = 1.0f - __expf(lf); }
}
__device__ __forceinline__ float hgrn_lb(const P& p, int j, int hk) {
    if (j == 0) return 0.f;
    const float a0 = p.in[14][hk], a1 = p.in[14][512 + hk];
    return 1.0f / (1.0f + __expf(a0 - a1));
}
__device__ __forceinline__ void hgrn_decode(int item, int& b, int& h, int& row0, int& ntok, int& uid) {
    if (item < 1040) { int seq, c; if (item < 1024) { seq = item >> 6; c = 1 + (item & 63); } else { seq = item - 1024; c = 0; }
        b = seq >> 2; h = seq & 3; row0 = c ? b * 4096 + (c - 1) * 64 : ROW_META + b * 16; ntok = c ? 64 : 16; uid = seq * 65 + c; }
    else { const int s = item - 1040; b = s >> 2; h = s & 3; row0 = ROW_SAMP + b * 32; ntok = 32; uid = item; }
}
__device__ __forceinline__ void stage_v(const bf16_t* QKV, int row0, int ntok, int h, LAS bf16_t* Vs, int tid) {
    for (int idx = tid; idx < 64 * 16; idx += 512) { const int t = idx >> 4, v0 = (idx & 15) * 8;
        u32x4 q = (u32x4){0u, 0u, 0u, 0u};
        if (t < ntok) q = *(const u32x4*)(QKV + (size_t)(row0 + t) * QKVW + 1792 + h * 128 + v0);
        LAS unsigned* d = (LAS unsigned*)(Vs + t * 130 + v0); d[0] = q.x; d[1] = q.y; d[2] = q.z; d[3] = q.w; }
}
__device__ __forceinline__ bf16x8 gather8(const LAS bf16_t* base, int stride) {
    u32x4 w;
    w.x = (unsigned)base[0] | ((unsigned)base[stride] << 16); w.y = (unsigned)base[2 * stride] | ((unsigned)base[3 * stride] << 16);
    w.z = (unsigned)base[4 * stride] | ((unsigned)base[5 * stride] << 16); w.w = (unsigned)base[6 * stride] | ((unsigned)base[7 * stride] << 16);
    return __builtin_bit_cast(bf16x8, w);
}
__device__ __forceinline__ void h1_item(const P& p, int j, int item, LAS unsigned char* lds) {
    const int tid = otid(), lane = tid & 63, w = tid >> 6, fr = lane & 15, fq = lane >> 4, tq = tid >> 7, k = tid & 127;
    const bf16_t* QKV = (const bf16_t*)(p.ws + WS_ACT);
    LAS bf16_t* Kh = (LAS bf16_t*)lds;
    LAS bf16_t* Vs = (LAS bf16_t*)(lds + 16640);
    LAS float* TOT = (LAS float*)(lds + 33280);
    int b, h, row0, ntok, uid; hgrn_decode(item, b, h, row0, ntok, uid);
    float cs[16], kin[16];
    hgrn_gates(QKV, row0, ntok, h, tq, k, cs, kin);
    __syncthreads();
    TOT[tq * 128 + k] = cs[15];
    stage_v(QKV, row0, ntok, h, Vs, tid);
    __syncthreads();
    const float t0 = TOT[k], t1 = TOT[128 + k], t2 = TOT[256 + k], t3 = TOT[384 + k];
    const float bC = (t0 + t1) + (t2 + t3);
    const float beta = tq == 0 ? 0.f : (tq == 1 ? t0 : (tq == 2 ? t0 + t1 : t0 + t1 + t2));
    if (tq * 16 < ntok) {
#pragma unroll
        for (int i = 0; i < 16; ++i) Kh[(tq * 16 + i) * 130 + k] = f2bf(kin[i] * __expf(bC - beta - cs[i]));
    } else {
#pragma unroll
        for (int i = 0; i < 16; ++i) Kh[(tq * 16 + i) * 130 + k] = (bf16_t)0;
    }
    if (tq == 0) ((float*)(p.ws + WS_DEC))[(size_t)uid * 128 + k] = __expf(bC);
    __syncthreads();
    const bf16x8 a0 = gather8(Vs + (8 * fq) * 130 + 16 * w + fr, 130), a1 = gather8(Vs + (32 + 8 * fq) * 130 + 16 * w + fr, 130);
    bf16_t* U = (bf16_t*)(p.ws + WS_U) + (size_t)uid * 16384;
#pragma unroll
    for (int kt = 0; kt < 8; ++kt) {
        const bf16x8 b0 = gather8(Kh + (8 * fq) * 130 + 16 * kt + fr, 130), b1 = gather8(Kh + (32 + 8 * fq) * 130 + 16 * kt + fr, 130);
        f32x4 acc = (f32x4){0.f, 0.f, 0.f, 0.f};
        acc = __builtin_amdgcn_mfma_f32_16x16x32_bf16(b0, a0, acc, 0, 0, 0); acc = __builtin_amdgcn_mfma_f32_16x16x32_bf16(b1, a1, acc, 0, 0, 0);
        { unsigned b0 = __float_as_uint(acc[0]), b1 = __float_as_uint(acc[1]), b2 = __float_as_uint(acc[2]), b3 = __float_as_uint(acc[3]);
          b0 = (b0 + 0x7fffu + ((b0 >> 16) & 1u)) >> 16; b1 = (b1 + 0x7fffu + ((b1 >> 16) & 1u)) >> 16; b2 = (b2 + 0x7fffu + ((b2 >> 16) & 1u)) >> 16; b3 = (b3 + 0x7fffu + ((b3 >> 16) & 1u)) >> 16;
          u32x2 uw; uw.x = b0 | (b1 << 16); uw.y = b2 | (b3 << 16); *(u32x2*)(U + (16 * w + fr) * 128 + 16 * kt + 4 * fq) = uw; }
    }
}
__device__ __forceinline__ void h2_phase(const P& p, int j) {
    const bf16_t* U = (const bf16_t*)(p.ws + WS_U); bf16_t* S = (bf16_t*)(p.ws + WS_S); const float* DEC = (const float*)(p.ws + WS_DEC);
    const int gid = obid() * 512 + otid(), nth = gridDim.x * 512;
    for (int e = gid; e < 16 * 8192; e += nth) {
        const int seq = e >> 13, r2 = (e & 8191) * 2, k = r2 & 127, v = r2 >> 7;
        float s0 = 0.f, s1 = 0.f; const size_t base = (size_t)seq * 65;
#pragma unroll 5
        for (int c = 0; c < 65; ++c) { const size_t uid = base + c;
            const unsigned uw = *(const unsigned*)(U + uid * 16384 + r2); const f32x2 u = (f32x2){lo_bf(uw), hi_bf(uw)}, d = *(const f32x2*)(DEC + uid * 128 + k);
            *(unsigned*)(S + uid * 16384 + r2) = pk2(s0, s1);
            s0 = d.x * s0 + u.x; s1 = d.y * s1 + u.y; }
        float* o = p.out + OFF_HP + ((size_t)(j * 16 + seq) * 128 + k) * 128 + v; o[0] = s0; o[128] = s1;
    }
    for (int e = gid; e < 32 * 8192; e += nth) {
        const int seq = e >> 13, r2 = (e & 8191) * 2, k = r2 & 127, v = r2 >> 7; const size_t uid = 1040 + seq;
        const float* sp = p.in[4] + ((size_t)(j * 32 + seq) * 128 + k) * 128 + v;
        const float a0 = sp[0], a1 = sp[128];
        const unsigned uw = *(const unsigned*)(U + uid * 16384 + r2); const f32x2 u = (f32x2){lo_bf(uw), hi_bf(uw)}, d = *(const f32x2*)(DEC + uid * 128 + k);
        *(unsigned*)(S + uid * 16384 + r2) = pk2(a0, a1);
        float* o = p.out + OFF_HS + ((size_t)(j * 32 + seq) * 128 + k) * 128 + v; o[0] = d.x * a0 + u.x; o[128] = d.y * a1 + u.y;
    }
}
__device__ __forceinline__ void h3_item(const P& p, int j, int item, LAS unsigned char* lds) {
    const int tid = otid(), lane = tid & 63, w = tid >> 6, fr = lane & 15, fq = lane >> 4, tq = tid >> 7, k = tid & 127;
    const bf16_t* QKV = (const bf16_t*)(p.ws + WS_ACT); bf16_t* CAT = (bf16_t*)(p.ws + WS_CAT);
    LAS bf16_t* Qp = (LAS bf16_t*)lds;
    LAS bf16_t* Qt = (LAS bf16_t*)(lds + 17408);
    LAS bf16_t* Kp = (LAS bf16_t*)(lds + 34816);
    LAS bf16_t* Ps = (LAS bf16_t*)(lds + 78336);
    LAS bf16_t* Vs = (LAS bf16_t*)(lds + 87552);
    LAS float* TOT = (LAS float*)(lds + 104192);
    LAS float* SS = (LAS float*)(lds + 106240);
    int b, h, row0, ntok, uid; hgrn_decode(item, b, h, row0, ntok, uid);
    const int nsb = ntok >> 4;
    float cs[16], kin[16];
    hgrn_gates(QKV, row0, ntok, h, tq, k, cs, kin);
    __syncthreads();
    TOT[tq * 128 + k] = cs[15];
    stage_v(QKV, row0, ntok, h, Vs, tid);
    __syncthreads();
    const float t0 = TOT[k], t1 = TOT[128 + k], t2 = TOT[256 + k];
    const float be1 = t0, be2 = t0 + t1, be3 = be2 + t2;
    const float beta = tq == 0 ? 0.f : (tq == 1 ? be1 : (tq == 2 ? be2 : be3));
    const float ebeta = __expf(beta);
    const bool valid = tq * 16 < ntok;
    if (valid) {
    bf16_t qraw[16];
    { const bf16_t* qsrc = QKV + (size_t)(row0 + tq * 16) * QKVW + 768 + h * 128 + k;
#pragma unroll
      for (int i = 0; i < 16; ++i) qraw[i] = qsrc[(size_t)i * QKVW]; }
#pragma unroll
    for (int i = 0; i < 16; ++i) {
        const int t = tq * 16 + i;
        const float q = bf2f(qraw[i]);
        const float qp = q * __expf(cs[i]);
        Qp[t * 136 + k] = f2bf(qp); Qt[t * 136 + k] = f2bf(qp * ebeta);
        const float base = -beta - cs[i];
        if (tq <= 0) Kp[(0 + t) * 136 + k] = f2bf(kin[i] * __expf(base));
        if (tq <= 1) Kp[(16 + t) * 136 + k] = f2bf(kin[i] * __expf(be1 + base));
        if (tq <= 2) Kp[(48 + t) * 136 + k] = f2bf(kin[i] * __expf(be2 + base));
        Kp[(96 + t) * 136 + k] = f2bf(kin[i] * __expf(be3 + base));
    }
    }
    __syncthreads();
    for (int tile = w; tile < 4 * nsb; tile += 8) {
        const int ti = tile >> 2, tj = tile & 3;
        f32x4 acc = (f32x4){0.f, 0.f, 0.f, 0.f};
        if (tj <= ti) {
            const int kb = 8 * ti * (ti + 1);
#pragma unroll
            for (int kk = 0; kk < 4; ++kk) {
                const bf16x8 a = *(const LAS bf16x8*)(Qp + (16 * ti + fr) * 136 + 32 * kk + 8 * fq), bb = *(const LAS bf16x8*)(Kp + (kb + 16 * tj + fr) * 136 + 32 * kk + 8 * fq);
                acc = __builtin_amdgcn_mfma_f32_16x16x32_bf16(a, bb, acc, 0, 0, 0);
            }
            const int lim = (tj == ti) ? 4 * fq : 64;
#pragma unroll
            for (int r = 0; r < 4; ++r) acc[r] = (fr > lim + r) ? 0.f : acc[r];
        }
#pragma unroll
        for (int r = 0; r < 4; ++r) Ps[(16 * ti + 4 * fq + r) * 72 + 16 * tj + fr] = f2bf(acc[r]);
    }
    __syncthreads();
    const bf16_t* ST = (const bf16_t*)(p.ws + WS_S) + (size_t)uid * 16384;
    bf16x8 sf[4];
#pragma unroll
    for (int kk = 0; kk < 4; ++kk) sf[kk] = *(const bf16x8*)(ST + (16 * w + fr) * 128 + 32 * kk + 8 * fq);
    const bf16x8 vf0 = gather8(Vs + (8 * fq) * 130 + 16 * w + fr, 130), vf1 = gather8(Vs + (32 + 8 * fq) * 130 + 16 * w + fr, 130);
    f32x4 o[4];
#pragma unroll
    for (int tt = 0; tt < 4; ++tt) {
        f32x4 acc = (f32x4){0.f, 0.f, 0.f, 0.f};
        if (tt < nsb) {
#pragma unroll
        for (int kk = 0; kk < 4; ++kk) { const bf16x8 a = *(const LAS bf16x8*)(Qt + (16 * tt + fr) * 136 + 32 * kk + 8 * fq); acc = __builtin_amdgcn_mfma_f32_16x16x32_bf16(sf[kk], a, acc, 0, 0, 0); }
        { const bf16x8 a = *(const LAS bf16x8*)(Ps + (16 * tt + fr) * 72 + 8 * fq); acc = __builtin_amdgcn_mfma_f32_16x16x32_bf16(vf0, a, acc, 0, 0, 0); }
        { const bf16x8 a = *(const LAS bf16x8*)(Ps + (16 * tt + fr) * 72 + 32 + 8 * fq); acc = __builtin_amdgcn_mfma_f32_16x16x32_bf16(vf1, a, acc, 0, 0, 0); }
        o[tt] = acc;
        float sq = (acc[0] * acc[0] + acc[1] * acc[1]) + (acc[2] * acc[2] + acc[3] * acc[3]);
        sq += __shfl_xor(sq, 16); sq += __shfl_xor(sq, 32);
        if (fq == 0) SS[w * 64 + 16 * tt + fr] = sq;
        }
    }
    const int v0 = 16 * w + 4 * fq; const f32x4 gain = *(const f32x4*)(p.in[15] + (j * 4 + h) * 128 + v0);
    u32x2 graw[4];
#pragma unroll
    for (int tt = 0; tt < 4; ++tt) { const int t = 16 * tt + fr; const int tc = t < ntok ? t : ntok - 1;
        graw[tt] = *(const u32x2*)(QKV + (size_t)(row0 + tc) * QKVW + 2304 + h * 128 + v0); }
    __syncthreads();
#pragma unroll
    for (int tt = 0; tt < 4; ++tt) if (tt < nsb) { const int t = 16 * tt + fr;
        float tot = 0.f;
#pragma unroll
        for (int ww = 0; ww < 8; ++ww) tot += SS[ww * 64 + t];
        const float rs = __builtin_amdgcn_rsqf(tot * (1.0f / 128.0f) + EPS);
        const f32x4 gt = (f32x4){lo_bf(graw[tt].x), hi_bf(graw[tt].x), lo_bf(graw[tt].y), hi_bf(graw[tt].y)};
        const f32x4 r4 = o[tt] * gain * gt * rs;
        u32x2 ow; ow.x = pk2(r4[0], r4[1]); ow.y = pk2(r4[2], r4[3]);
        if (t < ntok) *(u32x2*)(CAT + (size_t)(row0 + t) * DM + 512 + h * 128 + v0) = ow;
    }
}

template <class Sched> __device__ __forceinline__ void load_rstd_table(const P& p, const Sched& S, LAS unsigned char* lds) {
    const int tid = otid(); LAS float* T = (LAS float*)(lds + LDS_RSTD); const float* R = (const float*)(p.ws + WS_RSTD);
    pg8::Unit u;
    for (int i = 0; i < 7; ++i) { if (!S.next(i, u)) break; if (tid < 256) T[i * 256 + tid] = R[u.pm * 256 + tid]; }
    __syncthreads();
}

#define XB_TMO      128
#define XB_XCNT(j)  (256  + 64 * (j))
#define XB_XSUB(j)  (1280 + 64 * (j))
#define XB_XGEN(j)  (2304 + 64 * (j))
#define XB_TOP      3328
#define XB_TOPGEN   3392
#define XCD_BAR_WORDS 3456
#define XB_SPIN_CAP (1u << 18)
__device__ __forceinline__ unsigned xb_ld(unsigned* p)              { return __hip_atomic_load(p, __ATOMIC_RELAXED, __HIP_MEMORY_SCOPE_AGENT); }
__device__ __forceinline__ unsigned xb_add(unsigned* p, unsigned v) { return __hip_atomic_fetch_add(p, v, __ATOMIC_RELAXED, __HIP_MEMORY_SCOPE_AGENT); }
__device__ __forceinline__ unsigned xb_xcc_id() { return (unsigned)__builtin_amdgcn_s_getreg((3 << 11) | 20) & 0xFu; }
#define XB_SPIN(cond, bar) do { unsigned _sp = 0; while (cond) { __builtin_amdgcn_s_sleep(1); \
    if ((++_sp & 255u) == 0u) { if (xb_ld(&(bar)[XB_TMO])) break; if (_sp > XB_SPIN_CAP) { atomicAdd(&(bar)[XB_TMO], 1u); break; } } } } while (0)
struct XcdBarrier { unsigned* bar; unsigned x; volatile LAS unsigned* st; };
__device__ __forceinline__ XcdBarrier xcd_barrier_post(unsigned* bar, volatile LAS unsigned* st) {
    XcdBarrier b; b.bar = bar; b.x = xb_xcc_id(); b.st = st;
    if (threadIdx.x == 0) (void)xb_add(&bar[XB_XCNT(b.x)], 1u);
    return b;
}
__device__ __forceinline__ void xcd_barrier_complete(unsigned* bar, unsigned x, unsigned& nloc, unsigned& nx) {
    const unsigned G = gridDim.x * gridDim.y * gridDim.z;
    unsigned sum, cnt, mine, sp = 0u;
    for (;;) {
        sum = 0u; cnt = 0u; mine = 0u;
#pragma unroll
        for (unsigned j = 0; j < 16; ++j) { const unsigned c = xb_ld(&bar[XB_XCNT(j)]); sum += c; cnt += (c > 0u) ? 1u : 0u; mine = (j == x) ? c : mine; }
        if (sum == G) break;
        __builtin_amdgcn_s_sleep(1);
        if ((++sp & 255u) == 0u) { if (xb_ld(&bar[XB_TMO])) break; if (sp > XB_SPIN_CAP) { atomicAdd(&bar[XB_TMO], 1u); break; } }
    }
    nloc = mine > 0u ? mine : 1u; nx = cnt > 0u ? cnt : 1u;
}
__device__ __forceinline__ void xcd_barrier(const XcdBarrier& b) {
    asm volatile("s_waitcnt vmcnt(0)" ::: "memory");
    __syncthreads();
    if (threadIdx.x == 0) {
        unsigned* bar = b.bar;
        __builtin_amdgcn_s_waitcnt(0);
        unsigned nloc = b.st[0], nx = b.st[1];
        if (nloc == 0u) { xcd_barrier_complete(bar, b.x, nloc, nx); b.st[0] = nloc; b.st[1] = nx; }
        const unsigned old = xb_add(&bar[XB_XSUB(b.x)], 1u);
        const unsigned gen = old / nloc;
        if (old + 1u == (gen + 1u) * nloc) {
            __builtin_amdgcn_fence(__ATOMIC_RELEASE, "agent");
            asm volatile("s_waitcnt vmcnt(0)" ::: "memory");
            const unsigned og = xb_add(&bar[XB_TOP], 1u);
            const unsigned tg = og / nx;
            if (og + 1u == (tg + 1u) * nx) xb_add(&bar[XB_TOPGEN], 1u);
            else XB_SPIN(xb_ld(&bar[XB_TOPGEN]) == tg, bar);
            __builtin_amdgcn_fence(__ATOMIC_ACQUIRE, "agent");
            xb_add(&bar[XB_XGEN(b.x)], 1u);
            asm volatile("s_waitcnt vmcnt(0)" ::: "memory");
        } else {
            XB_SPIN(xb_ld(&bar[XB_XGEN(b.x)]) == gen, bar);
            __builtin_amdgcn_fence(__ATOMIC_ACQUIRE, "agent");
            asm volatile("s_waitcnt vmcnt(0)" ::: "memory");
        }
    }
    __syncthreads();
}

__global__ void __launch_bounds__(512, 2) mega(P p) {
    extern __shared__ __attribute__((aligned(16))) unsigned char shm[];
    LAS unsigned char* lds = (LAS unsigned char*)shm;
    cg::grid_group grid = cg::this_grid();
    if (threadIdx.x == 0) { ((volatile LAS unsigned*)(lds + LDS_MAIN))[0] = 0u; ((volatile LAS unsigned*)(lds + LDS_MAIN))[1] = 0u; }
    __syncthreads();
    const XcdBarrier bar = xcd_barrier_post((unsigned*)(p.ws + WS_CTL), (volatile LAS unsigned*)(lds + LDS_MAIN));
#define GRID_SYNC() do { xcd_barrier(bar); if (PROBE_DUP == 4) xcd_barrier(bar); } while (0)
    const int G = gridDim.x; int bid = blockIdx.x;
    unsigned my_rank = 0u, my_xcc = 0u;
    if (threadIdx.x == 0) { my_xcc = xb_xcc_id(); my_rank = xb_add((unsigned*)(p.ws + WS_CTL) + 8 * my_xcc, 1u); }
    const float* gains = p.in[7];
    bf16_t* H = (bf16_t*)(p.ws + WS_H); bf16_t* ACT = (bf16_t*)(p.ws + WS_ACT); bf16_t* CAT = (bf16_t*)(p.ws + WS_CAT);
    const bf16_t* XR = (const bf16_t*)(p.ws + WS_X);

    if (bid == 0) { for (int i = otid(); i < 1024; i += 512) ((float*)(p.ws + WS_LB))[i] = hgrn_lb(p, i >> 9, i & 511); }
    convert_weights(p, 0, lds, 0, 1 << 30, bid, G);
    norm_phase<0, 0>(p, nullptr, gains, 0.f);
    if (p.out == nullptr) grid.sync();
    GRID_SYNC();
    if (threadIdx.x == 0) { bool ok = (G == 256);
        for (unsigned x = 0; x < 16; ++x) ok = ok && (xb_ld((unsigned*)(p.ws + WS_CTL) + 8 * x) == (x < 8 ? 32u : 0u));
        ((volatile LAS unsigned*)(lds + LDS_MAIN))[4] = ok ? (my_rank * 8u + my_xcc) : (unsigned)blockIdx.x; }
    __syncthreads();
    bid = __builtin_amdgcn_readfirstlane((int)((volatile LAS unsigned*)(lds + LDS_MAIN))[4]);
    for (int step = 0; step < 12; ++step) {
        const int l = step / 3, kind = step - l * 3, j = l >> 1;
        const float* gl = gains + (size_t)l * 6 * DM;
        unsigned char* wb = p.ws + WS_W + (size_t)(l & 1) * W_END;
        const int ca1 = 4704, ca2 = ca1 + ((l & 1) ? 4992 : 1344), ca3 = ca2 + 4704;
        if (kind != 1) {
            const int which = kind >> 1;
            { pg8::Gemm g{XR, (const bf16_t*)(wb + (which ? W_GUB : W_GUA)), ROWS_PAD, 5632, 1024}; pg8::StaticOrder S; S.init(ROWS_PAD, 5632, 1024, G, bid); load_rstd_table(p, S, lds);
              EpiSwiglu E{ACT, FF}; pg8::gemm_phase(lds, g, S, E);
              if (l < 3 && bid >= 172) convert_weights(p, l + 1, lds, which ? ca2 : 0, which ? ca3 : ca1, bid - 172, G - 172);
              if (PROBE_DUP == 1) { GRID_SYNC(); pg8::gemm_phase(lds, g, S, E); } }
            GRID_SYNC();
            { pg8::Gemm g{ACT, (const bf16_t*)(wb + (which ? W_DB : W_DA)), ROWS_PAD, 1024, FF}; pg8::TailOrder S; S.init(FF, G, bid, PNT_D);
              EpiPlainTail E{H, (float*)(p.ws + WS_U)}; pg8::gemm_phase(lds, g, S, E);
              if (PROBE_DUP == 2) { GRID_SYNC(); pg8::gemm_phase(lds, g, S, E); } }
            GRID_SYNC();
            if (which == 0) norm_phase<1, 44 / PNT_D>(p, gl + 1 * DM, gl + 2 * DM, 0.5f);
            else if (l < 3) { norm_phase<1, 44 / PNT_D>(p, gl + 5 * DM, gl + 6 * DM, 0.5f); convert_weights(p, l + 1, lds, ca3, 1 << 30, bid, G); }
            else norm_phase<2, 44 / PNT_D>(p, gl + 5 * DM, nullptr, 0.5f);
            if (step != 11) GRID_SYNC();
        } else {
            if ((l & 1) == 0) {
                { pg8::Gemm g{XR, (const bf16_t*)(wb + W_IN), ROWS_PAD, 2816, 1024}; pg8::StaticOrder S; S.init(ROWS_PAD, 2816, 1024, G, bid); load_rstd_table(p, S, lds);
                  EpiEvenIn E{ACT, (const float*)(p.ws + WS_LB) + j * 512}; pg8::gemm_phase(lds, g, S, E);
                  if (l < 3 && bid >= 214) convert_weights(p, l + 1, lds, ca1, ca2, bid - 214, G - 214);
                  if (PROBE_DUP == 5) { GRID_SYNC(); pg8::gemm_phase(lds, g, S, E); } }
                GRID_SYNC();
                for (int rep = 0; rep < (PROBE_DUP == 3 ? 2 : 1); ++rep) {
                for (int r2 = 0; r2 < (PROBE_DUP == 6 || PROBE_DUP == 9 ? 2 : 1); ++r2) {
                for (int it = bid; it < 1072; it += G) h1_item(p, j, it, lds);
                GRID_SYNC(); }
                for (int r2 = 0; r2 < (PROBE_DUP == 7 ? 2 : 1); ++r2) {
                h2_phase(p, j);
                GRID_SYNC(); }
                for (int r2 = 0; r2 < (PROBE_DUP == 8 ? 2 : 1); ++r2) {
                for (int it = bid; it < 1072 + 536; it += G) { if (it < 1072) h3_item(p, j, it, lds); else att_item(p, j, it - 1072, lds); }
                GRID_SYNC(); }
                }
            } else {
                { pg8::Gemm g{XR, (const bf16_t*)(wb + W_IN), ROWS_PAD, 3072, 1024}; pg8::StaticOrder S; S.init(ROWS_PAD, 3072, 1024, G, bid); load_rstd_table(p, S, lds);
                  EpiOddIn E{ACT, ACT + (size_t)ROWS_PAD * 1024}; pg8::gemm_phase(lds, g, S, E);
                  if (l < 3 && bid >= 24) convert_weights(p, l + 1, lds, ca1, ca2, bid - 24, G - 24); }
                GRID_SYNC();
                conv_phase(p, j);
                GRID_SYNC();
            }
            { pg8::Gemm g{CAT, (const bf16_t*)(wb + W_OUT), ROWS_PAD, 1024, 1024}; pg8::TailOrder S; S.init(1024, G, bid, PNT_O);
              EpiPlainTail E{H, (float*)(p.ws + WS_U)}; pg8::gemm_phase(lds, g, S, E); }
            GRID_SYNC();
            norm_phase<1, 16 / PNT_O>(p, gl + 3 * DM, gl + 4 * DM, 1.0f);
            GRID_SYNC();
        }
    }
}

extern "C" void kernel_launch(void* const* d_in, const int* in_sizes, int n_in, void* d_out, int out_size, void* d_ws, size_t ws_size, hipStream_t stream) {
    static int grid_blocks = 0;
    if (grid_blocks == 0) {
        if (n_in != 19 || ws_size < WS_END) { fprintf(stderr, "kernel_launch: need 19 inputs and %zu bytes of workspace (got %d, %zu)\n", (size_t)WS_END, n_in, ws_size); grid_blocks = -1; return; }
        int dev = 0, cus = 0, per_cu = 0;
        hipGetDevice(&dev);
        hipDeviceGetAttribute(&cus, hipDeviceAttributeMultiprocessorCount, dev);
        if (hipFuncSetAttribute((const void*)mega, hipFuncAttributeMaxDynamicSharedMemorySize, LDS_BYTES) != hipSuccess) { fprintf(stderr, "kernel_launch: hipFuncSetAttribute failed\n"); grid_blocks = -1; return; }
        hipOccupancyMaxActiveBlocksPerMultiprocessor(&per_cu, (const void*)mega, 512, LDS_BYTES);
        if (per_cu < 1) { fprintf(stderr, "kernel_launch: occupancy query says %d blocks per CU\n", per_cu); per_cu = 1; }
        (void)hipGetLastError();
        grid_blocks = cus * 1;
        if (grid_blocks != 256) { fprintf(stderr, "kernel_launch: built for a 256-CU device (got %d CUs); nothing launched\n", cus); grid_blocks = -1; return; }
    }
    if (grid_blocks < 0) return;
    if (hipMemsetAsync((char*)d_ws + WS_CTL, 0, CTL_BYTES, stream) != hipSuccess) { fprintf(stderr, "kernel_launch: memset of barrier words failed\n"); return; }
    P p{};
    for (int i = 0; i < 19; ++i) p.in[i] = (const float*)d_in[i];
    p.out = (float*)d_out; p.ws = (unsigned char*)d_ws;
    void* args[] = {&p};
    hipError_t e = hipLaunchCooperativeKernel((const void*)mega, dim3(grid_blocks), dim3(512), args, LDS_BYTES, stream);
    if (e != hipSuccess) fprintf(stderr, "cooperative launch failed: %s (grid %d)\n", hipGetErrorString(e), grid_blocks);
}
```

```cpp
#include <hip/hip_runtime.h>
#include <hip/hip_cooperative_groups.h>
#include <cstdio>
namespace cg = cooperative_groups;

#define LAS __attribute__((address_space(3)))
typedef unsigned short bf16_t;
typedef short bf16x8 __attribute__((ext_vector_type(8)));
typedef float f32x4 __attribute__((ext_vector_type(4)));
typedef float f32x2 __attribute__((ext_vector_type(2)));
typedef unsigned u32x4 __attribute__((ext_vector_type(4)));
typedef unsigned u32x2 __attribute__((ext_vector_type(2)));

#define PROBE_DUP 0
#define PNT_D 2
#define PNT_O 2
constexpr int DM = 1024, FF = 2816;
constexpr int ROW_META = 16384, ROW_SAMP = 16448, ROWS = 16704, ROWS_PAD = 16896;
constexpr int QKVW = 2816;
constexpr float EPS = 1e-6f;
constexpr size_t OFF_YP = 0, OFF_YS = 16777216, OFF_KP = 17039360, OFF_VP = 17170432, OFF_HP = 17301504, OFF_CP = 17825792,
                 OFF_KS = 17842176, OFF_VS = 18104320, OFF_HS = 18366464, OFF_CS = 19415040;
constexpr size_t WS_X = 0;
constexpr size_t WS_H = WS_X + (size_t)ROWS_PAD * 1024 * 2;
constexpr size_t WS_ACT = WS_H + (size_t)ROWS_PAD * 1024 * 2;
constexpr size_t WS_CAT = WS_ACT + (size_t)ROWS_PAD * 3072 * 2;
constexpr size_t WS_W = WS_CAT + (size_t)ROWS_PAD * 1024 * 2;
constexpr size_t W_GUA = 0, W_DA = W_GUA + (size_t)5632 * 1024 * 2, W_GUB = W_DA + (size_t)1024 * 2816 * 2, W_DB = W_GUB + (size_t)5632 * 1024 * 2,
                 W_IN = W_DB + (size_t)1024 * 2816 * 2, W_OUT = W_IN + (size_t)3072 * 1024 * 2, W_END = W_OUT + (size_t)1024 * 1024 * 2;
constexpr size_t WS_U = WS_W + 2 * W_END;
constexpr size_t WS_S = WS_U + (size_t)1072 * 16384 * 4;
constexpr size_t WS_DEC = WS_S + (size_t)1072 * 16384 * 2;
constexpr size_t WS_CTL = WS_DEC + (size_t)1072 * 128 * 4;
constexpr size_t CTL_BYTES = 16384;
constexpr size_t WS_RSTD = WS_CTL + CTL_BYTES;
constexpr size_t WS_LB = WS_RSTD + (size_t)ROWS_PAD * 4;
constexpr size_t WS_END = WS_LB + 4096;
constexpr int LDS_MAIN = 131072, LDS_RSTD = LDS_MAIN + 64, LDS_BYTES = LDS_RSTD + 7 * 1024;

struct P { const float* in[19]; float* out; unsigned char* ws; };

__device__ __forceinline__ float bf2f(bf16_t v) { return __uint_as_float(((unsigned)v) << 16); }
__device__ __forceinline__ unsigned pk2(float lo, float hi) { unsigned r; asm volatile("v_cvt_pk_bf16_f32 %0, %1, %2" : "=v"(r) : "v"(lo), "v"(hi)); return r; }
__device__ __forceinline__ bf16_t f2bf(float f) { return (bf16_t)(pk2(f, 0.f) & 0xffffu); }
__device__ __forceinline__ float lo_bf(unsigned w) { return __uint_as_float(w << 16); }
__device__ __forceinline__ float hi_bf(unsigned w) { return __uint_as_float(w & 0xffff0000u); }
__device__ __forceinline__ float silu_f(float x) { return x * __builtin_amdgcn_rcpf(1.0f + __expf(-x)); }
__device__ __forceinline__ float wave_sum(float v) {
#pragma unroll
    for (int o = 1; o < 64; o <<= 1) v += __shfl_xor(v, o);
    return v;
}

__device__ __forceinline__ int otid() { int t = threadIdx.x; asm volatile("" : "+v"(t)); return t; }
__device__ __forceinline__ int obid() { int t = blockIdx.x; asm volatile("" : "+s"(t)); return t; }

namespace pg8 {
#define PG8_LAS __attribute__((address_space(3)))
constexpr int BM = 256, BK = 64, HALF = 128, HTB = HALF * BK * 2, STAGE_BYTES = 8 * HTB, NXCD = 8, WGM = 8;
__host__ __device__ __forceinline__ int lds_byte(int r, int c) { const int st = (r >> 4) * 2 + (c >> 5), rr = r & 15, cc = c & 31, ob = rr * 64 + cc * 2; return st * 1024 + (ob ^ (((ob >> 9) & 1) << 5)); }
__host__ __device__ __forceinline__ void stage_rc(int b, int& R, int& C) { const int st = b / 1024, sb = b % 1024, swz = sb ^ (((sb >> 9) & 1) << 5); R = (st >> 1) * 16 + swz / 64; C = (st & 1) * 32 + (swz % 64) / 2; }
__host__ __device__ __forceinline__ int perm32(int rho) { const int n = rho >> 4, i = rho & 15; return 8 * (i >> 2) + 4 * n + (i & 3); }
struct Unit { int pm, pn, k0, nt, piece; };
struct Gemm { const bf16_t* A; const bf16_t* Bt; int M, N, K; };
struct StaticOrder {
    int nM, nN, nwg, G, c, ntk;
    __device__ void init(int M, int N, int K, int G_, int c_) { nM = M / BM; nN = N / BM; nwg = nM * nN; G = G_; c = c_; ntk = K / BK; }
    __device__ bool next(int i, Unit& u) const {
        const long L = (long)i * G + c; if (L >= nwg) return false;
        u.k0 = 0; u.nt = ntk; u.piece = -1;
        int wgid = (int)L; { const int q = nwg / NXCD, r = nwg % NXCD, xcd = wgid % NXCD, off = wgid / NXCD; wgid = (xcd < r ? xcd * (q + 1) : r * (q + 1) + (xcd - r) * q) + off; }
        const int nig = WGM * nN, gid = wgid / nig, fm = gid * WGM, gsz = (nM - fm) < WGM ? (nM - fm) : WGM;
        const int rem = wgid - gid * nig;
        if (gsz == WGM) { u.pm = fm + (rem & (WGM - 1)); u.pn = rem >> 3; } else { u.pm = fm + rem % gsz; u.pn = rem / gsz; }
        return true;
    }
};
struct TailOrder {
    int G, c, ntk, pnt, ppu, npieces;
    __device__ void init(int K, int G_, int c_, int pnt_) { G = G_; c = c_; ntk = K / BK; pnt = pnt_; ppu = ntk / pnt_; npieces = 8 * ppu; }
    __device__ bool next(int i, Unit& u) const {
        const int L = i * G + c;
        if (L < 256) { const int wgid = (L & 7) * 32 + (L >> 3); u.pm = (wgid >> 5) * 8 + (wgid & 7); u.pn = (wgid & 31) >> 3; u.k0 = 0; u.nt = ntk; u.piece = -1; return true; }
        const int pi = L - 256; if (pi >= npieces) return false;
        const int tu = pi / ppu, pc = pi - tu * ppu; u.pm = 64 + (tu >> 2); u.pn = tu & 3; u.k0 = pc * pnt; u.nt = pnt; u.piece = pc; return true;
    }
};
template <class Epi, class Sched>
__device__ __forceinline__ void gemm_phase(PG8_LAS unsigned char* lds, const Gemm g, const Sched& S, const Epi& E) {
    const int tid = otid(), wid = __builtin_amdgcn_readfirstlane(tid >> 6), lane = tid & 63, wr = wid >> 2, wc = wid & 3, fr = lane & 15, fq = lane >> 4;
    const int K = g.K;
    unsigned voffA[2], voffB[2];
#pragma unroll
    for (int i = 0; i < 2; ++i) { int R, C; stage_rc(tid * 16 + i * 8192, R, C); const int Rb = (R & ~31) + perm32(R & 31);
        voffA[i] = (unsigned)(R * K + C) * 2u; voffB[i] = (unsigned)(Rb * K + C) * 2u; }
    const size_t kstep = (size_t)(BK * 2);
    const size_t hstep = (size_t)HALF * K * 2;
    const size_t tstep = 2 * hstep;
    const unsigned ldsw = (unsigned)wid * 1024u;
    const int aoff = lds_byte(wr * 64 + fr, fq * 8), boff = lds_byte(wc * 32 + fr, fq * 8);
#define PG8_SA(b, h) (((b) * 2 + (h)) * HTB)
#define PG8_SB(b, h) ((4 + (b) * 2 + (h)) * HTB)
#define PG8_STAGE(bufoff, gbase, voff) do { _Pragma("unroll") for (int _i = 0; _i < 2; ++_i) \
        __builtin_amdgcn_global_load_lds((const unsigned*)((const char*)(gbase) + (voff)[_i]), (PG8_LAS unsigned*)(lds + (bufoff) + ldsw + _i * 8192), 16, 0, 0); } while (0)
#define PG8_LDA(dst, b, h) do { _Pragma("unroll") for (int m = 0; m < 4; ++m) _Pragma("unroll") for (int k = 0; k < 2; ++k) dst[m][k] = *(const PG8_LAS bf16x8*)(lds + PG8_SA(b, h) + aoff + m * 2048 + k * 1024); } while (0)
#define PG8_LDB(dst, b, h) do { _Pragma("unroll") for (int n = 0; n < 2; ++n) _Pragma("unroll") for (int k = 0; k < 2; ++k) dst[n][k] = *(const PG8_LAS bf16x8*)(lds + PG8_SB(b, h) + boff + n * 2048 + k * 1024); } while (0)
#define PG8_MMA(ai, bj, At, Bt) do { __builtin_amdgcn_s_setprio(1); _Pragma("unroll") for (int m = 0; m < 4; ++m) _Pragma("unroll") for (int n = 0; n < 2; ++n) _Pragma("unroll") for (int k = 0; k < 2; ++k) \
        acc[ai][bj][m][n] = __builtin_amdgcn_mfma_f32_16x16x32_bf16(Bt[n][k], At[m][k], acc[ai][bj][m][n], 0, 0, 0); __builtin_amdgcn_s_setprio(0); } while (0)
#define PG8_WAIT_V(n) asm volatile("s_waitcnt vmcnt(" #n ")" ::: "memory")
#define PG8_WAIT_L(n) asm volatile("s_waitcnt lgkmcnt(" #n ")" ::: "memory")
#define PG8_BAR __builtin_amdgcn_s_barrier()
#define PG8_SCHED __builtin_amdgcn_sched_barrier(0)
    Unit cur, nxt; int ui = 0;
    if (!S.next(0, cur)) return;
    f32x4 acc[2][2][4][2];
#pragma unroll
    for (int a = 0; a < 2; ++a)
#pragma unroll
        for (int b = 0; b < 2; ++b)
#pragma unroll
            for (int m = 0; m < 4; ++m)
#pragma unroll
                for (int n = 0; n < 2; ++n) acc[a][b][m][n] = (f32x4){0.f, 0.f, 0.f, 0.f};
    bf16x8 At[4][2], B0[2][2], B1[2][2];
    const char* cA = (const char*)g.A + (size_t)cur.pm * tstep + (size_t)cur.k0 * kstep; const char* cB = (const char*)g.Bt + (size_t)cur.pn * tstep + (size_t)cur.k0 * kstep;
    PG8_STAGE(PG8_SB(0, 0), cB, voffB); PG8_STAGE(PG8_SA(0, 0), cA, voffA); PG8_STAGE(PG8_SB(0, 1), cB + hstep, voffB); PG8_STAGE(PG8_SA(0, 1), cA + hstep, voffA);
    if (wr == 1) PG8_BAR;
    PG8_WAIT_V(4); PG8_BAR;
    PG8_STAGE(PG8_SB(1, 0), cB + kstep, voffB); PG8_STAGE(PG8_SA(1, 0), cA + kstep, voffA); PG8_STAGE(PG8_SB(1, 1), cB + hstep + kstep, voffB);
    PG8_WAIT_V(6); PG8_BAR;
    for (;;) {
        const bool has_next = S.next(ui + 1, nxt);
        const char* nA = has_next ? (const char*)g.A + (size_t)nxt.pm * tstep + (size_t)nxt.k0 * kstep : cA; const char* nB = has_next ? (const char*)g.Bt + (size_t)nxt.pn * tstep + (size_t)nxt.k0 * kstep : cB;
        const int nt = cur.nt;
        for (int t = 0; t < nt; t += 2) {
            const bool last = (t == nt - 2);
            const char* a1 = cA + (size_t)(t + 1) * kstep;
            const char* a2 = last ? nA : cA + (size_t)(t + 2) * kstep; const char* b2 = last ? nB : cB + (size_t)(t + 2) * kstep;
            const char* a3 = a2 + kstep; const char* b3 = b2 + kstep;
            PG8_LDB(B0, 0, 0); PG8_SCHED; PG8_LDA(At, 0, 0); PG8_STAGE(PG8_SA(1, 1), a1 + hstep, voffA);
            PG8_WAIT_L(8); PG8_BAR; PG8_WAIT_L(0); PG8_MMA(0, 0, At, B0); PG8_BAR; PG8_SCHED;
            PG8_LDB(B1, 0, 1); PG8_STAGE(PG8_SB(0, 0), b2, voffB);
            PG8_BAR; PG8_WAIT_L(0); PG8_MMA(0, 1, At, B1); PG8_BAR;
            PG8_LDA(At, 0, 1); PG8_STAGE(PG8_SA(0, 0), a2, voffA);
            PG8_BAR; PG8_WAIT_L(0); PG8_MMA(1, 0, At, B0); PG8_BAR; PG8_SCHED;
            PG8_STAGE(PG8_SB(0, 1), b2 + hstep, voffB);
            PG8_WAIT_V(6); PG8_BAR; PG8_MMA(1, 1, At, B1); PG8_BAR;
            PG8_LDB(B0, 1, 0); PG8_SCHED; PG8_LDA(At, 1, 0); PG8_STAGE(PG8_SA(0, 1), a2 + hstep, voffA);
            PG8_WAIT_L(8); PG8_BAR; PG8_WAIT_L(0); PG8_MMA(0, 0, At, B0); PG8_BAR; PG8_SCHED;
            PG8_LDB(B1, 1, 1); PG8_STAGE(PG8_SB(1, 0), b3, voffB);
            PG8_BAR; PG8_WAIT_L(0); PG8_MMA(0, 1, At, B1); PG8_BAR;
            PG8_LDA(At, 1, 1); PG8_STAGE(PG8_SA(1, 0), a3, voffA);
            PG8_BAR; PG8_WAIT_L(0); PG8_MMA(1, 0, At, B0); PG8_BAR; PG8_SCHED;
            PG8_STAGE(PG8_SB(1, 1), b3 + hstep, voffB);
            PG8_WAIT_V(6); PG8_BAR; PG8_MMA(1, 1, At, B1); PG8_BAR;
        }
        E(acc, cur, wr, wc, fr, fq, ui, (const LAS float*)(lds + LDS_RSTD));
        if (!has_next) break;
#pragma unroll
        for (int a = 0; a < 2; ++a)
#pragma unroll
            for (int b = 0; b < 2; ++b)
#pragma unroll
                for (int m = 0; m < 4; ++m)
#pragma unroll
                    for (int n = 0; n < 2; ++n) { f32x4 z; asm volatile("v_pk_mov_b32 %0, 0, 0\n\tv_pk_mov_b32 %1, 0, 0" : "=v"(*(f32x2*)&z), "=v"(*((f32x2*)&z + 1))); acc[a][b][m][n] = z; }
        cur = nxt; cA = nA; cB = nB; ++ui;
    }
    PG8_WAIT_V(0);
    if (wr == 0) PG8_BAR;
    PG8_BAR;
#undef PG8_SA
#undef PG8_SB
#undef PG8_STAGE
#undef PG8_LDA
#undef PG8_LDB
#undef PG8_MMA
#undef PG8_WAIT_V
#undef PG8_WAIT_L
#undef PG8_BAR
#undef PG8_SCHED
}
}

struct EpiPlain {
    bf16_t* O; int ldc;
    __device__ __forceinline__ void operator()(const f32x4 (&acc)[2][2][4][2], const pg8::Unit& u, int wr, int wc, int fr, int fq, int ui, const LAS float* RS) const {
        const int row0 = u.pm * 256 + wr * 64 + fr, col0 = u.pn * 256 + wc * 32 + 8 * fq;
#pragma unroll
        for (int ai = 0; ai < 2; ++ai)
#pragma unroll
            for (int m = 0; m < 4; ++m) { bf16_t* rowp = O + (size_t)(row0 + ai * 128 + m * 16) * ldc + col0; const float rs = RS[ui * 256 + wr * 64 + fr + ai * 128 + m * 16];
#pragma unroll
                for (int bj = 0; bj < 2; ++bj) { const f32x4 v0 = acc[ai][bj][m][0] * rs, v1 = acc[ai][bj][m][1] * rs;
                    u32x4 w; w.x = pk2(v0[0], v0[1]); w.y = pk2(v0[2], v0[3]); w.z = pk2(v1[0], v1[1]); w.w = pk2(v1[2], v1[3]);
                    *(u32x4*)(rowp + bj * 128) = w; } }
    }
};
__device__ __forceinline__ f32x2 silu_pk(f32x2 t) {
    const f32x2 a = t * (-1.44269504f);
    f32x2 e; e.x = __builtin_amdgcn_exp2f(a.x); e.y = __builtin_amdgcn_exp2f(a.y);
    const f32x2 d = e + 1.0f;
    f32x2 r; r.x = __builtin_amdgcn_rcpf(d.x); r.y = __builtin_amdgcn_rcpf(d.y);
    return t * r;
}
struct EpiEvenIn {
    static constexpr bool PERM = true, AFTER_DRAIN = false;
    bf16_t* O; const float* LB;
    __device__ __forceinline__ void operator()(const f32x4 (&acc)[2][2][4][2], const pg8::Unit& u, int wr, int wc, int fr, int fq, int ui, const LAS float* RS) const {
        const int row0 = u.pm * 256 + wr * 64 + fr, col0 = u.pn * 256 + wc * 32 + 8 * fq;
        const int kind = (u.pn == 3 || u.pn == 4 || u.pn >= 9) ? 1 : ((u.pn == 5 || u.pn == 6) ? 2 : 0);
        f32x4 lbv[2][2];
        if (kind == 2) {
#pragma unroll
            for (int bj = 0; bj < 2; ++bj)
#pragma unroll
                for (int n = 0; n < 2; ++n) { const f32x4 t = *(const f32x4*)(LB + (col0 - 1280) + bj * 128 + 4 * n); lbv[bj][n] = (f32x4){fmaxf(t[0], 1e-30f), fmaxf(t[1], 1e-30f), fmaxf(t[2], 1e-30f), fmaxf(t[3], 1e-30f)}; }
        }
#pragma unroll
        for (int ai = 0; ai < 2; ++ai)
#pragma unroll
            for (int m = 0; m < 4; ++m) { bf16_t* rowp = O + (size_t)(row0 + ai * 128 + m * 16) * QKVW + col0; const float rs = RS[ui * 256 + wr * 64 + fr + ai * 128 + m * 16];
#pragma unroll
                for (int bj = 0; bj < 2; ++bj) { f32x4 v[2] = {acc[ai][bj][m][0] * rs, acc[ai][bj][m][1] * rs};
                    if (kind == 1) {
#pragma unroll
                        for (int n = 0; n < 2; ++n) { const f32x2 s0 = silu_pk((f32x2){v[n][0], v[n][1]}), s1 = silu_pk((f32x2){v[n][2], v[n][3]}); v[n] = (f32x4){s0.x, s0.y, s1.x, s1.y}; }
                    } else if (kind == 2) {
#pragma unroll
                        for (int n = 0; n < 2; ++n)
#pragma unroll
                            for (int h2 = 0; h2 < 2; ++h2) { const f32x2 x = (f32x2){v[n][2 * h2], v[n][2 * h2 + 1]}, lb2 = (f32x2){lbv[bj][n][2 * h2], lbv[bj][n][2 * h2 + 1]};
                                const f32x2 a = __builtin_elementwise_abs(x) * (-1.44269504f);
                                f32x2 ex; ex.x = __builtin_amdgcn_exp2f(a.x); ex.y = __builtin_amdgcn_exp2f(a.y);
                                const f32x2 d = ex + 1.0f; f32x2 r; r.x = __builtin_amdgcn_rcpf(d.x); r.y = __builtin_amdgcn_rcpf(d.y);
                                const f32x2 sm = ex * r;
                                f32x2 sp, sn; sp.x = x.x >= 0.f ? r.x : sm.x; sp.y = x.y >= 0.f ? r.y : sm.y; sn.x = x.x >= 0.f ? sm.x : r.x; sn.y = x.y >= 0.f ? sm.y : r.y;
                                const f32x2 f = sp + lb2 * sn;
                                v[n][2 * h2] = __builtin_amdgcn_logf(f.x) * 0.69314718f; v[n][2 * h2 + 1] = __builtin_amdgcn_logf(f.y) * 0.69314718f; }
                    }
                    u32x4 w; w.x = pk2(v[0][0], v[0][1]); w.y = pk2(v[0][2], v[0][3]); w.z = pk2(v[1][0], v[1][1]); w.w = pk2(v[1][2], v[1][3]);
                    *(u32x4*)(rowp + bj * 128) = w; } }
    }
};
struct EpiPlainTail {
    bf16_t* O; float* PT;
    __device__ __forceinline__ void operator()(const f32x4 (&acc)[2][2][4][2], const pg8::Unit& u, int wr, int wc, int fr, int fq, int ui, const LAS float* RS) const {
        const int row0 = u.pm * 256 + wr * 64 + fr, col0 = u.pn * 256 + wc * 32 + 8 * fq;
        if (u.piece < 0) {
#pragma unroll
            for (int ai = 0; ai < 2; ++ai)
#pragma unroll
                for (int m = 0; m < 4; ++m) { bf16_t* rowp = O + (size_t)(row0 + ai * 128 + m * 16) * 1024 + col0;
#pragma unroll
                    for (int bj = 0; bj < 2; ++bj) { const f32x4 v0 = acc[ai][bj][m][0], v1 = acc[ai][bj][m][1];
                        u32x4 w; w.x = pk2(v0[0], v0[1]); w.y = pk2(v0[2], v0[3]); w.z = pk2(v1[0], v1[1]); w.w = pk2(v1[2], v1[3]);
                        *(u32x4*)(rowp + bj * 128) = w; } }
        } else {
            bf16_t* base = (bf16_t*)PT + (size_t)u.piece * 320 * 1024;
#pragma unroll
            for (int ai = 0; ai < 2; ++ai)
#pragma unroll
                for (int m = 0; m < 4; ++m) { const int row = row0 + ai * 128 + m * 16;
                    if (row < ROWS) { bf16_t* rowp = base + (size_t)(row - ROW_META) * 1024 + col0;
#pragma unroll
                        for (int bj = 0; bj < 2; ++bj) { const f32x4 v0 = acc[ai][bj][m][0], v1 = acc[ai][bj][m][1];
                            u32x4 w; w.x = pk2(v0[0], v0[1]); w.y = pk2(v0[2], v0[3]); w.z = pk2(v1[0], v1[1]); w.w = pk2(v1[2], v1[3]);
                            *(u32x4*)(rowp + bj * 128) = w; } } }
        }
    }
};
__device__ __forceinline__ f32x2 swiglu_pk(f32x2 g, f32x2 u, f32x2 crs, f32x2 rs2) {
    const f32x2 a = g * crs;
    f32x2 e; e.x = __builtin_amdgcn_exp2f(a.x); e.y = __builtin_amdgcn_exp2f(a.y);
    const f32x2 d = e + 1.0f;
    f32x2 r; r.x = __builtin_amdgcn_rcpf(d.x); r.y = __builtin_amdgcn_rcpf(d.y);
    return ((g * u) * rs2) * r;
}
struct EpiSwiglu {
    static constexpr bool PERM = true, AFTER_DRAIN = false;
    bf16_t* O; int ldc;
    __device__ __forceinline__ void operator()(const f32x4 (&acc)[2][2][4][2], const pg8::Unit& u, int wr, int wc, int fr, int fq, int ui, const LAS float* RS) const {
        const int row0 = u.pm * 256 + wr * 64 + fr, col0 = u.pn * 128 + wc * 32 + 8 * fq;
#pragma unroll
        for (int ai = 0; ai < 2; ++ai)
#pragma unroll
            for (int m = 0; m < 4; ++m) { bf16_t* rowp = O + (size_t)(row0 + ai * 128 + m * 16) * ldc + col0; const float rs = RS[ui * 256 + wr * 64 + fr + ai * 128 + m * 16];
                const float crs_ = -1.44269504f * rs, rsq_ = rs * rs; const f32x2 crs = (f32x2){crs_, crs_}, rs2 = (f32x2){rsq_, rsq_};
                const f32x4 g0 = acc[ai][0][m][0], g1 = acc[ai][0][m][1], u0 = acc[ai][1][m][0], u1 = acc[ai][1][m][1];
                const f32x2 o0 = swiglu_pk((f32x2){g0[0], g0[1]}, (f32x2){u0[0], u0[1]}, crs, rs2), o1 = swiglu_pk((f32x2){g0[2], g0[3]}, (f32x2){u0[2], u0[3]}, crs, rs2);
                const f32x2 o2 = swiglu_pk((f32x2){g1[0], g1[1]}, (f32x2){u1[0], u1[1]}, crs, rs2), o3 = swiglu_pk((f32x2){g1[2], g1[3]}, (f32x2){u1[2], u1[3]}, crs, rs2);
                u32x4 w; w.x = pk2(o0.x, o0.y); w.y = pk2(o1.x, o1.y); w.z = pk2(o2.x, o2.y); w.w = pk2(o3.x, o3.y);
                *(u32x4*)rowp = w; }
    }
};
struct EpiOddIn {
    bf16_t* U; bf16_t* BG;
    __device__ __forceinline__ void operator()(const f32x4 (&acc)[2][2][4][2], const pg8::Unit& u, int wr, int wc, int fr, int fq, int ui, const LAS float* RS) const {
        const int row0 = u.pm * 256 + wr * 64 + fr;
        if (u.pn < 8) {
            const int col0 = u.pn * 128 + wc * 32 + 8 * fq;
#pragma unroll
            for (int ai = 0; ai < 2; ++ai)
#pragma unroll
                for (int m = 0; m < 4; ++m) { bf16_t* rowp = U + (size_t)(row0 + ai * 128 + m * 16) * 1024 + col0; const float rs = RS[ui * 256 + wr * 64 + fr + ai * 128 + m * 16], rs2 = rs * rs;
                    const f32x4 c0 = acc[ai][0][m][0], x0 = acc[ai][1][m][0], c1 = acc[ai][0][m][1], x1 = acc[ai][1][m][1]; const f32x2 r2 = (f32x2){rs2, rs2};
                    const f32x2 p0 = ((f32x2){c0[0], c0[1]} * (f32x2){x0[0], x0[1]}) * r2, p1 = ((f32x2){c0[2], c0[3]} * (f32x2){x0[2], x0[3]}) * r2;
                    const f32x2 p2 = ((f32x2){c1[0], c1[1]} * (f32x2){x1[0], x1[1]}) * r2, p3 = ((f32x2){c1[2], c1[3]} * (f32x2){x1[2], x1[3]}) * r2;
                    u32x4 w; w.x = pk2(p0.x, p0.y); w.y = pk2(p1.x, p1.y); w.z = pk2(p2.x, p2.y); w.w = pk2(p3.x, p3.y);
                    *(u32x4*)rowp = w; }
        } else {
            const int col0 = (u.pn - 8) * 256 + wc * 32 + 8 * fq;
#pragma unroll
            for (int ai = 0; ai < 2; ++ai)
#pragma unroll
                for (int m = 0; m < 4; ++m) { bf16_t* rowp = BG + (size_t)(row0 + ai * 128 + m * 16) * 1024 + col0; const float rs = RS[ui * 256 + wr * 64 + fr + ai * 128 + m * 16];
#pragma unroll
                    for (int bj = 0; bj < 2; ++bj) { const f32x4 v0 = acc[ai][bj][m][0] * rs, v1 = acc[ai][bj][m][1] * rs;
                        u32x4 w; w.x = pk2(v0[0], v0[1]); w.y = pk2(v0[2], v0[3]); w.z = pk2(v1[0], v1[1]); w.w = pk2(v1[2], v1[3]);
                        *(u32x4*)(rowp + bj * 128) = w; } }
        }
    }
};

__device__ __forceinline__ int dst_row(int mode, int n) {
    if (mode == 0) return n;
    if (mode == 1) return (n >> 7) * 256 + (n & 127);
    if (mode == 2) return (n >> 7) * 256 + 128 + (n & 127);
    if (n < 1024) return 2048 + n;
    if (n < 2048) { const int c = n - 1024; return (c >> 7) * 256 + (c & 127); }
    { const int c = n - 2048; return (c >> 7) * 256 + 128 + (c & 127); }
}
__device__ __forceinline__ void transpose_item(const float* W, int K, int N, bf16_t* WT, int mode, LAS float* scr, int item, int lane, const float* gk = nullptr) {
    const int nblk = N / 32, kb = item / nblk, nb = item % nblk, k0 = 64 * kb, n0 = 32 * nb;
    { const int kr = lane >> 3, c4 = (lane & 7) * 4;
      f32x4 v[8];
#pragma unroll
      for (int i = 0; i < 8; ++i) v[i] = *(const f32x4*)(W + (size_t)(k0 + 8 * i + kr) * N + n0 + c4);
#pragma unroll
      for (int i = 0; i < 8; ++i) { const int kk = 8 * i + kr; f32x4 t = v[i]; if (gk) t *= gk[k0 + kk];
          LAS float* d = scr + kk * 33 + c4; d[0] = t[0]; d[1] = t[1]; d[2] = t[2]; d[3] = t[3]; } }
    asm volatile("s_waitcnt lgkmcnt(0)" ::: "memory");
    const int c = lane & 7; const int r0 = dst_row(mode, n0);
#pragma unroll
    for (int j = 0; j < 4; ++j) { const int n = (lane >> 3) + 8 * j; const LAS float* s = scr + (8 * c) * 33 + n;
        u32x4 o; o.x = pk2(s[0 * 33], s[1 * 33]); o.y = pk2(s[2 * 33], s[3 * 33]); o.z = pk2(s[4 * 33], s[5 * 33]); o.w = pk2(s[6 * 33], s[7 * 33]);
        *(u32x4*)(WT + (size_t)(r0 + n) * K + k0 + 8 * c) = o; }
    asm volatile("s_waitcnt lgkmcnt(0)" ::: "memory");
}
__device__ __forceinline__ void convert_weights(const P& p, int l, LAS unsigned char* lds, int it0, int it1, int wg, int NW) {
    const int tid_ = otid(); const int lane = tid_ & 63, wave = tid_ >> 6;
    LAS float* scr = (LAS float*)(lds + wave * 8704);
    const int gw = wg * 8 + wave, NGW = NW * 8;
    unsigned char* wb = p.ws + WS_W + (size_t)(l & 1) * W_END; const int j = l >> 1; const bool odd = l & 1;
    constexpr int I_GU = 16 * 88, I_D = 44 * 32, I_OUT = 16 * 32;
    const int I_IN = odd ? 16 * 96 : 16 * 88;
    const int NIT = 6 * I_GU + I_IN + I_OUT;
    if (it1 > NIT) it1 = NIT;
    const size_t gsz = (size_t)1024 * 2816;
    const float* ga = p.in[7] + (size_t)(l * 6 + 0) * DM; const float* gm = p.in[7] + (size_t)(l * 6 + 2) * DM; const float* gb = p.in[7] + (size_t)(l * 6 + 4) * DM;
    for (int it = it0 + gw; it < it1; it += NGW) {
        int r = it;
        if (r < I_GU) { transpose_item(p.in[8] + (size_t)(l * 2 + 0) * gsz, 1024, 2816, (bf16_t*)(wb + W_GUA), 1, scr, r, lane, ga); continue; } r -= I_GU;
        if (r < I_GU) { transpose_item(p.in[9] + (size_t)(l * 2 + 0) * gsz, 1024, 2816, (bf16_t*)(wb + W_GUA), 2, scr, r, lane, ga); continue; } r -= I_GU;
        if (r < I_D) { transpose_item(p.in[10] + (size_t)(l * 2 + 0) * gsz, 2816, 1024, (bf16_t*)(wb + W_DA), 0, scr, r, lane); continue; } r -= I_D;
        if (r < I_GU) { transpose_item(p.in[8] + (size_t)(l * 2 + 1) * gsz, 1024, 2816, (bf16_t*)(wb + W_GUB), 1, scr, r, lane, gb); continue; } r -= I_GU;
        if (r < I_GU) { transpose_item(p.in[9] + (size_t)(l * 2 + 1) * gsz, 1024, 2816, (bf16_t*)(wb + W_GUB), 2, scr, r, lane, gb); continue; } r -= I_GU;
        if (r < I_D) { transpose_item(p.in[10] + (size_t)(l * 2 + 1) * gsz, 2816, 1024, (bf16_t*)(wb + W_DB), 0, scr, r, lane); continue; } r -= I_D;
        if (r < I_IN) {
            if (odd) transpose_item(p.in[16] + (size_t)j * 1024 * 3072, 1024, 3072, (bf16_t*)(wb + W_IN), 3, scr, r, lane, gm);
            else transpose_item(p.in[11] + (size_t)j * 1024 * 2816, 1024, 2816, (bf16_t*)(wb + W_IN), 0, scr, r, lane, gm);
            continue; } r -= I_IN;
        transpose_item((odd ? p.in[18] : p.in[12]) + (size_t)j * 1024 * 1024, 1024, 1024, (bf16_t*)(wb + W_OUT), 0, scr, r, lane);
    }
}

template <int MODE, int NPART>
__device__ __forceinline__ void norm_phase(const P& p, const float* gA, const float* gB, float alpha) {
    const int tid_ = otid(); const int lane = tid_ & 63, wave = tid_ >> 6;
    const int gw = obid() * 8 + wave;
    bf16_t* X = (bf16_t*)(p.ws + WS_X); bf16_t* H = (bf16_t*)(p.ws + WS_H);
    if (MODE == 0 && gw < ROWS_PAD - ROWS) {
        const int row = ROWS + gw; bf16_t* C0 = (bf16_t*)(p.ws + WS_CAT);
#pragma unroll
        for (int jj = 0; jj < 4; ++jj) { *(u32x2*)(X + (size_t)row * DM + lane * 4 + 256 * jj) = (u32x2){0u, 0u}; *(u32x2*)(C0 + (size_t)row * DM + lane * 4 + 256 * jj) = (u32x2){0u, 0u}; }
        if (lane == 0) ((float*)(p.ws + WS_RSTD))[row] = 0.f;
    }
    for (int it = 0; it < 9; ++it) {
        int row;
        if (MODE == 0) row = gw + it * 2048;
        else if (it < 7) row = gw + 2048 * it;
        else if (it == 7) row = gw < 320 ? ROW_META + gw : gw + 2048 * 7;
        else row = (gw >= 320 && gw < 640) ? 14336 + (gw - 320) : ROWS;
        if (row >= ROWS) break;
        f32x4 x[4];
        if (MODE == 0) { const float* xsrc = row < ROW_META ? p.in[0] + (size_t)row * DM : (row < ROW_SAMP ? p.in[6] + (size_t)((row - ROW_META) & 15) * DM : p.in[1] + (size_t)(row - ROW_SAMP) * DM);
#pragma unroll
            for (int jj = 0; jj < 4; ++jj) x[jj] = *(const f32x4*)(xsrc + lane * 4 + 256 * jj); }
        else {
#pragma unroll
            for (int jj = 0; jj < 4; ++jj) { const u32x2 w = *(const u32x2*)(X + (size_t)row * DM + lane * 4 + 256 * jj); x[jj] = (f32x4){lo_bf(w.x), hi_bf(w.x), lo_bf(w.y), hi_bf(w.y)}; } }
        if (MODE != 0) {
            f32x4 y[4]; float ss = 0.f;
            if (row < ROW_META) {
#pragma unroll
                for (int jj = 0; jj < 4; ++jj) { const u32x2 w = *(const u32x2*)(H + (size_t)row * DM + lane * 4 + 256 * jj);
                    y[jj] = (f32x4){lo_bf(w.x), hi_bf(w.x), lo_bf(w.y), hi_bf(w.y)}; }
            } else {
                const bf16_t* pt = (const bf16_t*)(p.ws + WS_U) + (size_t)(row - ROW_META) * DM + lane * 4;
#pragma unroll
                for (int jj = 0; jj < 4; ++jj) y[jj] = (f32x4){0.f, 0.f, 0.f, 0.f};
                u32x2 part[NPART > 0 ? NPART : 1][4];
#pragma unroll
                for (int pc = 0; pc < NPART; ++pc)
#pragma unroll
                    for (int jj = 0; jj < 4; ++jj) part[pc][jj] = *(const u32x2*)(pt + (size_t)pc * 320 * 1024 + 256 * jj);
#pragma unroll
                for (int pc = 0; pc < NPART; ++pc)
#pragma unroll
                    for (int jj = 0; jj < 4; ++jj) y[jj] += (f32x4){lo_bf(part[pc][jj].x), hi_bf(part[pc][jj].x), lo_bf(part[pc][jj].y), hi_bf(part[pc][jj].y)};
            }
#pragma unroll
            for (int jj = 0; jj < 4; ++jj) ss += (y[jj][0] * y[jj][0] + y[jj][1] * y[jj][1]) + (y[jj][2] * y[jj][2] + y[jj][3] * y[jj][3]);
            const float rs = alpha * __builtin_amdgcn_rsqf(wave_sum(ss) * (1.0f / DM) + EPS);
#pragma unroll
            for (int jj = 0; jj < 4; ++jj) { const f32x4 g = *(const f32x4*)(gA + lane * 4 + 256 * jj); x[jj] += y[jj] * g * rs; }
        }
        if (MODE == 2) {
            float* o = row < ROW_META ? p.out + OFF_YP + (size_t)row * DM : (row >= ROW_SAMP ? p.out + OFF_YS + (size_t)(row - ROW_SAMP) * DM : nullptr);
            if (o) {
#pragma unroll
                for (int jj = 0; jj < 4; ++jj) *(f32x4*)(o + lane * 4 + 256 * jj) = x[jj];
            }
        } else {
            float ss = 0.f;
#pragma unroll
            for (int jj = 0; jj < 4; ++jj) { u32x2 xw; xw.x = pk2(x[jj][0], x[jj][1]); xw.y = pk2(x[jj][2], x[jj][3]); *(u32x2*)(X + (size_t)row * DM + lane * 4 + 256 * jj) = xw;
                ss += (x[jj][0] * x[jj][0] + x[jj][1] * x[jj][1]) + (x[jj][2] * x[jj][2] + x[jj][3] * x[jj][3]); }
            const float rs = __builtin_amdgcn_rsqf(wave_sum(ss) * (1.0f / DM) + EPS);
            if (lane == 0) ((float*)(p.ws + WS_RSTD))[row] = rs;
        }
    }
}

__device__ __forceinline__ void conv_phase(const P& p, int j) {
    const int tid_ = otid(); const int lane = tid_ & 63, wave = tid_ >> 6;
    const int gw = obid() * 8 + wave, NGW = gridDim.x * 8;
    const bf16_t* U = (const bf16_t*)(p.ws + WS_ACT); const bf16_t* BG = U + (size_t)ROWS_PAD * 1024; bf16_t* CAT = (bf16_t*)(p.ws + WS_CAT);
    const float* cw = p.in[17] + (size_t)j * 3 * DM; const float* cache = p.in[5] + (size_t)j * 8 * 2 * DM;
    for (int row = gw; row < ROWS; row += NGW) {
        int r1 = -1, r2 = -1; const float* c1 = nullptr; const float* c2 = nullptr; float* so = nullptr;
        if (row < ROW_META) { const int b = row >> 12, t = row & 4095;
            r1 = t >= 1 ? row - 1 : ROW_META + b * 16 + 15; r2 = t >= 2 ? row - 2 : ROW_META + b * 16 + 14 + t;
            if (t >= 4094) so = p.out + OFF_CP + (size_t)((j * 4 + b) * 2 + (t - 4094)) * DM;
        } else if (row < ROW_SAMP) { const int i = (row - ROW_META) & 15; if (i >= 1) r1 = row - 1; if (i >= 2) r2 = row - 2; }
        else { const int b = (row - ROW_SAMP) >> 5, t = (row - ROW_SAMP) & 31;
            if (t >= 1) r1 = row - 1; else c1 = cache + (size_t)(b * 2 + 1) * DM;
            if (t >= 2) r2 = row - 2; else c2 = cache + (size_t)(b * 2 + t) * DM;
            if (t >= 30) so = p.out + OFF_CS + (size_t)((j * 8 + b) * 2 + (t - 30)) * DM; }
#pragma unroll
        for (int jj = 0; jj < 4; ++jj) { const int col = lane * 4 + 256 * jj;
            const u32x2 wu = *(const u32x2*)(U + (size_t)row * DM + col), wb = *(const u32x2*)(BG + (size_t)row * DM + col);
            const f32x4 u0 = (f32x4){lo_bf(wu.x), hi_bf(wu.x), lo_bf(wu.y), hi_bf(wu.y)}, bg = (f32x4){lo_bf(wb.x), hi_bf(wb.x), lo_bf(wb.y), hi_bf(wb.y)};
            f32x4 u1 = (f32x4){0.f, 0.f, 0.f, 0.f}, u2 = u1;
            if (r1 >= 0) { const u32x2 w = *(const u32x2*)(U + (size_t)r1 * DM + col); u1 = (f32x4){lo_bf(w.x), hi_bf(w.x), lo_bf(w.y), hi_bf(w.y)}; } else if (c1) u1 = *(const f32x4*)(c1 + col);
            if (r2 >= 0) { const u32x2 w = *(const u32x2*)(U + (size_t)r2 * DM + col); u2 = (f32x4){lo_bf(w.x), hi_bf(w.x), lo_bf(w.y), hi_bf(w.y)}; } else if (c2) u2 = *(const f32x4*)(c2 + col);
            const f32x4 w0 = *(const f32x4*)(cw + col), w1 = *(const f32x4*)(cw + DM + col), w2 = *(const f32x4*)(cw + 2 * DM + col);
            const f32x4 y = bg * (u2 * w0 + u1 * w1 + u0 * w2);
            u32x2 o; o.x = pk2(y[0], y[1]); o.y = pk2(y[2], y[3]); *(u32x2*)(CAT + (size_t)row * DM + col) = o;
            if (so) *(f32x4*)(so + col) = u0; }
    }
}

__device__ __forceinline__ void att_item(const P& p, int j, int item, LAS unsigned char* lds) {
    const int tid = otid(), lane = tid & 63, w = tid >> 6, fr = lane & 15, fq = lane >> 4;
    const bf16_t* QKV = (const bf16_t*)(p.ws + WS_ACT); bf16_t* CAT = (bf16_t*)(p.ws + WS_CAT);
    LAS bf16_t* Ks = (LAS bf16_t*)lds;
    LAS bf16_t* Vt = (LAS bf16_t*)(lds + 27648);
    const bool samp = item >= 520;
    int b, c, kv, nq, nkeys, qrow0;
    if (!samp) { kv = item & 1; const int bc = item >> 1; c = bc % 65; b = bc / 65; nq = c ? 64 : 16; qrow0 = c ? b * 4096 + (c - 1) * 64 : ROW_META + b * 16; nkeys = c >= 3 ? 192 : 16 + 64 * c; }
    else { const int s = item - 520; kv = s & 1; b = s >> 1; c = 0; nq = 32; qrow0 = ROW_SAMP + b * 32; nkeys = 160; }
    __syncthreads();
    for (int idx = tid; idx < 192 * 8; idx += 512) {
        const int s = idx >> 3, d0 = (idx & 7) * 8;
        f32x4 ka = (f32x4){0.f, 0.f, 0.f, 0.f}, kb = ka, va = ka, vb = ka;
        if (s < nkeys) {
            if (samp && s < 128) {
                const size_t o = ((size_t)((j * 8 + b) * 128 + s) * 2 + kv) * 64 + d0;
                ka = *(const f32x4*)(p.in[2] + o); kb = *(const f32x4*)(p.in[2] + o + 4); va = *(const f32x4*)(p.in[3] + o); vb = *(const f32x4*)(p.in[3] + o + 4);
            } else {
                int row;
                if (samp) row = ROW_SAMP + b * 32 + (s - 128);
                else if (c >= 3) row = b * 4096 + (c - 3) * 64 + s;
                else row = s < 16 ? ROW_META + b * 16 + s : b * 4096 + (s - 16);
                const u32x4 kq = *(const u32x4*)(QKV + (size_t)row * QKVW + 512 + kv * 64 + d0), vq = *(const u32x4*)(QKV + (size_t)row * QKVW + 640 + kv * 64 + d0);
                ka = (f32x4){lo_bf(kq.x), hi_bf(kq.x), lo_bf(kq.y), hi_bf(kq.y)}; kb = (f32x4){lo_bf(kq.z), hi_bf(kq.z), lo_bf(kq.w), hi_bf(kq.w)};
                va = (f32x4){lo_bf(vq.x), hi_bf(vq.x), lo_bf(vq.y), hi_bf(vq.y)}; vb = (f32x4){lo_bf(vq.z), hi_bf(vq.z), lo_bf(vq.w), hi_bf(vq.w)};
            }
            float* ok = nullptr; float* ov = nullptr;
            if (samp) { if (s >= 32) { const size_t o = ((size_t)((j * 8 + b) * 128 + (s - 32)) * 2 + kv) * 64 + d0; ok = p.out + OFF_KS + o; ov = p.out + OFF_VS + o; } }
            else if (c >= 63 && s >= 128) { const size_t o = ((size_t)((j * 4 + b) * 128 + (c - 63) * 64 + (s - 128)) * 2 + kv) * 64 + d0; ok = p.out + OFF_KP + o; ov = p.out + OFF_VP + o; }
            if (ok) { *(f32x4*)ok = ka; *(f32x4*)(ok + 4) = kb; *(f32x4*)ov = va; *(f32x4*)(ov + 4) = vb; }
        }
        u32x4 kw; kw.x = pk2(ka[0], ka[1]); kw.y = pk2(ka[2], ka[3]); kw.z = pk2(kb[0], kb[1]); kw.w = pk2(kb[2], kb[3]);
        *(LAS u32x4*)(Ks + s * 72 + d0) = kw;
        const unsigned v0 = pk2(va[0], va[1]), v1 = pk2(va[2], va[3]), v2 = pk2(vb[0], vb[1]), v3 = pk2(vb[2], vb[3]);
        Vt[(d0 + 0) * 200 + s] = (bf16_t)(v0 & 0xffffu); Vt[(d0 + 1) * 200 + s] = (bf16_t)(v0 >> 16);
        Vt[(d0 + 2) * 200 + s] = (bf16_t)(v1 & 0xffffu); Vt[(d0 + 3) * 200 + s] = (bf16_t)(v1 >> 16);
        Vt[(d0 + 4) * 200 + s] = (bf16_t)(v2 & 0xffffu); Vt[(d0 + 5) * 200 + s] = (bf16_t)(v2 >> 16);
        Vt[(d0 + 6) * 200 + s] = (bf16_t)(v3 & 0xffffu); Vt[(d0 + 7) * 200 + s] = (bf16_t)(v3 >> 16);
    }
    __syncthreads();
    const int nqt = nq >> 4, ntile = 4 * nqt, nkt = nkeys >> 4;
    for (int tt = w; tt < ntile; tt += 8) {
        const int g = tt / nqt, ttile = tt - g * nqt, hd = kv * 4 + g;
        const int row = qrow0 + ttile * 16 + fr;
        const bf16x8 qf0 = *(const bf16x8*)(QKV + (size_t)row * QKVW + hd * 64 + fq * 8), qf1 = *(const bf16x8*)(QKV + (size_t)row * QKVW + hd * 64 + 32 + fq * 8);
        const float sink = p.in[13][j * 8 + hd];
        f32x4 sc[12];
#pragma unroll
        for (int kt = 0; kt < 12; ++kt) {
            if (kt < nkt) {
                const bf16x8 k0 = *(const LAS bf16x8*)(Ks + (kt * 16 + fr) * 72 + fq * 8), k1 = *(const LAS bf16x8*)(Ks + (kt * 16 + fr) * 72 + 32 + fq * 8);
                f32x4 a = (f32x4){0.f, 0.f, 0.f, 0.f};
                a = __builtin_amdgcn_mfma_f32_16x16x32_bf16(k0, qf0, a, 0, 0, 0); a = __builtin_amdgcn_mfma_f32_16x16x32_bf16(k1, qf1, a, 0, 0, 0);
                sc[kt] = a * 0.125f;
            } else sc[kt] = (f32x4){-1e30f, -1e30f, -1e30f, -1e30f};
        }
        float mx = sink;
#pragma unroll
        for (int kt = 0; kt < 12; ++kt) mx = fmaxf(mx, fmaxf(fmaxf(sc[kt][0], sc[kt][1]), fmaxf(sc[kt][2], sc[kt][3])));
        mx = fmaxf(mx, __shfl_xor(mx, 16)); mx = fmaxf(mx, __shfl_xor(mx, 32));
        float sum = 0.f;
#pragma unroll
        for (int kt = 0; kt < 12; ++kt) {
#pragma unroll
            for (int r = 0; r < 4; ++r) { const float e = __expf(sc[kt][r] - mx); sc[kt][r] = e; sum += e; } }
        sum += __shfl_xor(sum, 16); sum += __shfl_xor(sum, 32);
        sum += __expf(sink - mx);
        const float inv = 1.0f / sum;
        f32x4 o[4];
#pragma unroll
        for (int dt = 0; dt < 4; ++dt) o[dt] = (f32x4){0.f, 0.f, 0.f, 0.f};
#pragma unroll
        for (int jj = 0; jj < 6; ++jj) {
            if (2 * jj < nkt) {
                u32x4 pw; pw.x = pk2(sc[2 * jj][0], sc[2 * jj][1]); pw.y = pk2(sc[2 * jj][2], sc[2 * jj][3]); pw.z = pk2(sc[2 * jj + 1][0], sc[2 * jj + 1][1]); pw.w = pk2(sc[2 * jj + 1][2], sc[2 * jj + 1][3]);
                const bf16x8 pf = __builtin_bit_cast(bf16x8, pw);
#pragma unroll
                for (int dt = 0; dt < 4; ++dt) {
                    const u32x2 lo = *(const LAS u32x2*)(Vt + (dt * 16 + fr) * 200 + 32 * jj + 4 * fq), hi = *(const LAS u32x2*)(Vt + (dt * 16 + fr) * 200 + 32 * jj + 16 + 4 * fq);
                    u32x4 vw; vw.x = lo.x; vw.y = lo.y; vw.z = hi.x; vw.w = hi.y;
                    o[dt] = __builtin_amdgcn_mfma_f32_16x16x32_bf16(__builtin_bit_cast(bf16x8, vw), pf, o[dt], 0, 0, 0);
                }
            }
        }
        bf16_t* orow = CAT + (size_t)row * DM + hd * 64 + 4 * fq;
#pragma unroll
        for (int dt = 0; dt < 4; ++dt) { u32x2 ow; ow.x = pk2(o[dt][0] * inv, o[dt][1] * inv); ow.y = pk2(o[dt][2] * inv, o[dt][3] * inv); *(u32x2*)(orow + dt * 16) = ow; }
    }
}

__device__ __forceinline__ void hgrn_gates(const bf16_t* QKV, int row0, int ntok, int h, int tq, int k, float (&cs)[16], float (&kin)[16]) {
    const bool valid = tq * 16 < ntok;
    float run = 0.f;
    if (!valid) {
#pragma unroll
        for (int i = 0; i < 16; ++i) { cs[i] = 0.f; kin[i] = 0.f; }
        return;
    }
    const bf16_t* src = QKV + (size_t)(row0 + tq * 16) * QKVW + 1280 + h * 128 + k;
    bf16_t raw[16];
#pragma unroll
    for (int i = 0; i < 16; ++i) raw[i] = src[(size_t)i * QKVW];
#pragma unroll
    for (int i = 0; i < 16; ++i) { const float lf = bf2f(raw[i]); run += lf; cs[i] = run; kin[i] = 1.0f - __expf(lf); }
}
__device__ __forceinline__ float hgrn_lb(const P& p, int j, int hk) {
    if (j == 0) return 0.f;
    const float a0 = p.in[14][hk], a1 = p.in[14][512 + hk];
    return 1.0f / (1.0f + __expf(a0 - a1));
}
__device__ __forceinline__ void hgrn_decode(int item, int& b, int& h, int& row0, int& ntok, int& uid) {
    if (item < 1040) { int seq, c; if (item < 1024) { seq = item >> 6; c = 1 + (item & 63); } else { seq = item - 1024; c = 0; }
        b = seq >> 2; h = seq & 3; row0 = c ? b * 4096 + (c - 1) * 64 : ROW_META + b * 16; ntok = c ? 64 : 16; uid = seq * 65 + c; }
    else { const int s = item - 1040; b = s >> 2; h = s & 3; row0 = ROW_SAMP + b * 32; ntok = 32; uid = item; }
}
__device__ __forceinline__ void stage_v(const bf16_t* QKV, int row0, int ntok, int h, LAS bf16_t* Vs, int tid) {
    for (int idx = tid; idx < 64 * 16; idx += 512) { const int t = idx >> 4, v0 = (idx & 15) * 8;
        u32x4 q = (u32x4){0u, 0u, 0u, 0u};
        if (t < ntok) q = *(const u32x4*)(QKV + (size_t)(row0 + t) * QKVW + 1792 + h * 128 + v0);
        LAS unsigned* d = (LAS unsigned*)(Vs + t * 130 + v0); d[0] = q.x; d[1] = q.y; d[2] = q.z; d[3] = q.w; }
}
__device__ __forceinline__ bf16x8 gather8(const LAS bf16_t* base, int stride) {
    u32x4 w;
    w.x = (unsigned)base[0] | ((unsigned)base[stride] << 16); w.y = (unsigned)base[2 * stride] | ((unsigned)base[3 * stride] << 16);
    w.z = (unsigned)base[4 * stride] | ((unsigned)base[5 * stride] << 16); w.w = (unsigned)base[6 * stride] | ((unsigned)base[7 * stride] << 16);
    return __builtin_bit_cast(bf16x8, w);
}
__device__ __forceinline__ void h1_item(const P& p, int j, int item, LAS unsigned char* lds) {
    const int tid = otid(), lane = tid & 63, w = tid >> 6, fr = lane & 15, fq = lane >> 4, tq = tid >> 7, k = tid & 127;
    const bf16_t* QKV = (const bf16_t*)(p.ws + WS_ACT);
    LAS bf16_t* Kh = (LAS bf16_t*)lds;
    LAS bf16_t* Vs = (LAS bf16_t*)(lds + 16640);
    LAS float* TOT = (LAS float*)(lds + 33280);
    int b, h, row0, ntok, uid; hgrn_decode(item, b, h, row0, ntok, uid);
    float cs[16], kin[16];
    hgrn_gates(QKV, row0, ntok, h, tq, k, cs, kin);
    __syncthreads();
    TOT[tq * 128 + k] = cs[15];
    stage_v(QKV, row0, ntok, h, Vs, tid);
    __syncthreads();
    const float t0 = TOT[k], t1 = TOT[128 + k], t2 = TOT[256 + k], t3 = TOT[384 + k];
    const float bC = (t0 + t1) + (t2 + t3);
    const float beta = tq == 0 ? 0.f : (tq == 1 ? t0 : (tq == 2 ? t0 + t1 : t0 + t1 + t2));
    if (tq * 16 < ntok) {
#pragma unroll
        for (int i = 0; i < 16; ++i) Kh[(tq * 16 + i) * 130 + k] = f2bf(kin[i] * __expf(bC - beta - cs[i]));
    } else {
#pragma unroll
        for (int i = 0; i < 16; ++i) Kh[(tq * 16 + i) * 130 + k] = (bf16_t)0;
    }
    if (tq == 0) ((float*)(p.ws + WS_DEC))[(size_t)uid * 128 + k] = __expf(bC);
    __syncthreads();
    const bf16x8 a0 = gather8(Vs + (8 * fq) * 130 + 16 * w + fr, 130), a1 = gather8(Vs + (32 + 8 * fq) * 130 + 16 * w + fr, 130);
    bf16_t* U = (bf16_t*)(p.ws + WS_U) + (size_t)uid * 16384;
#pragma unroll
    for (int kt = 0; kt < 8; ++kt) {
        const bf16x8 b0 = gather8(Kh + (8 * fq) * 130 + 16 * kt + fr, 130), b1 = gather8(Kh + (32 + 8 * fq) * 130 + 16 * kt + fr, 130);
        f32x4 acc = (f32x4){0.f, 0.f, 0.f, 0.f};
        acc = __builtin_amdgcn_mfma_f32_16x16x32_bf16(b0, a0, acc, 0, 0, 0); acc = __builtin_amdgcn_mfma_f32_16x16x32_bf16(b1, a1, acc, 0, 0, 0);
        { unsigned b0 = __float_as_uint(acc[0]), b1 = __float_as_uint(acc[1]), b2 = __float_as_uint(acc[2]), b3 = __float_as_uint(acc[3]);
          b0 = (b0 + 0x7fffu + ((b0 >> 16) & 1u)) >> 16; b1 = (b1 + 0x7fffu + ((b1 >> 16) & 1u)) >> 16; b2 = (b2 + 0x7fffu + ((b2 >> 16) & 1u)) >> 16; b3 = (b3 + 0x7fffu + ((b3 >> 16) & 1u)) >> 16;
          u32x2 uw; uw.x = b0 | (b1 << 16); uw.y = b2 | (b3 << 16); *(u32x2*)(U + (16 * w + fr) * 128 + 16 * kt + 4 * fq) = uw; }
    }
}
__device__ __forceinline__ void h2_phase(const P& p, int j) {
    const bf16_t* U = (const bf16_t*)(p.ws + WS_U); bf16_t* S = (bf16_t*)(p.ws + WS_S); const float* DEC = (const float*)(p.ws + WS_DEC);
    const int gid = obid() * 512 + otid(), nth = gridDim.x * 512;
    for (int e = gid; e < 16 * 8192; e += nth) {
        const int seq = e >> 13, r2 = (e & 8191) * 2, k = r2 & 127, v = r2 >> 7;
        float s0 = 0.f, s1 = 0.f; const size_t base = (size_t)seq * 65;
#pragma unroll 5
        for (int c = 0; c < 65; ++c) { const size_t uid = base + c;
            const unsigned uw = *(const unsigned*)(U + uid * 16384 + r2); const f32x2 u = (f32x2){lo_bf(uw), hi_bf(uw)}, d = *(const f32x2*)(DEC + uid * 128 + k);
            *(unsigned*)(S + uid * 16384 + r2) = pk2(s0, s1);
            s0 = d.x * s0 + u.x; s1 = d.y * s1 + u.y; }
        float* o = p.out + OFF_HP + ((size_t)(j * 16 + seq) * 128 + k) * 128 + v; o[0] = s0; o[128] = s1;
    }
    for (int e = gid; e < 32 * 8192; e += nth) {
        const int seq = e >> 13, r2 = (e & 8191) * 2, k = r2 & 127, v = r2 >> 7; const size_t uid = 1040 + seq;
        const float* sp = p.in[4] + ((size_t)(j * 32 + seq) * 128 + k) * 128 + v;
        const float a0 = sp[0], a1 = sp[128];
        const unsigned uw = *(const unsigned*)(U + uid * 16384 + r2); const f32x2 u = (f32x2){lo_bf(uw), hi_bf(uw)}, d = *(const f32x2*)(DEC + uid * 128 + k);
        *(unsigned*)(S + uid * 16384 + r2) = pk2(a0, a1);
        float* o = p.out + OFF_HS + ((size_t)(j * 32 + seq) * 128 + k) * 128 + v; o[0] = d.x * a0 + u.x; o[128] = d.y * a1 + u.y;
    }
}
__device__ __forceinline__ void h3_item(const P& p, int j, int item, LAS unsigned char* lds) {
    const int tid = otid(), lane = tid & 63, w = tid >> 6, fr = lane & 15, fq = lane >> 4, tq = tid >> 7, k = tid & 127;
    const bf16_t* QKV = (const bf16_t*)(p.ws + WS_ACT); bf16_t* CAT = (bf16_t*)(p.ws + WS_CAT);
    LAS bf16_t* Qp = (LAS bf16_t*)lds;
    LAS bf16_t* Qt = (LAS bf16_t*)(lds + 17408);
    LAS bf16_t* Kp = (LAS bf16_t*)(lds + 34816);
    LAS bf16_t* Ps = (LAS bf16_t*)(lds + 78336);
    LAS bf16_t* Vs = (LAS bf16_t*)(lds + 87552);
    LAS float* TOT = (LAS float*)(lds + 104192);
    LAS float* SS = (LAS float*)(lds + 106240);
    int b, h, row0, ntok, uid; hgrn_decode(item, b, h, row0, ntok, uid);
    const int nsb = ntok >> 4;
    float cs[16], kin[16];
    hgrn_gates(QKV, row0, ntok, h, tq, k, cs, kin);
    __syncthreads();
    TOT[tq * 128 + k] = cs[15];
    stage_v(QKV, row0, ntok, h, Vs, tid);
    __syncthreads();
    const float t0 = TOT[k], t1 = TOT[128 + k], t2 = TOT[256 + k];
    const float be1 = t0, be2 = t0 + t1, be3 = be2 + t2;
    const float beta = tq == 0 ? 0.f : (tq == 1 ? be1 : (tq == 2 ? be2 : be3));
    const float ebeta = __expf(beta);
    const bool valid = tq * 16 < ntok;
    if (valid) {
    bf16_t qraw[16];
    { const bf16_t* qsrc = QKV + (size_t)(row0 + tq * 16) * QKVW + 768 + h * 128 + k;
#pragma unroll
      for (int i = 0; i < 16; ++i) qraw[i] = qsrc[(size_t)i * QKVW]; }
#pragma unroll
    for (int i = 0; i < 16; ++i) {
        const int t = tq * 16 + i;
        const float q = bf2f(qraw[i]);
        const float qp = q * __expf(cs[i]);
        Qp[t * 136 + k] = f2bf(qp); Qt[t * 136 + k] = f2bf(qp * ebeta);
        const float base = -beta - cs[i];
        if (tq <= 0) Kp[(0 + t) * 136 + k] = f2bf(kin[i] * __expf(base));
        if (tq <= 1) Kp[(16 + t) * 136 + k] = f2bf(kin[i] * __expf(be1 + base));
        if (tq <= 2) Kp[(48 + t) * 136 + k] = f2bf(kin[i] * __expf(be2 + base));
        Kp[(96 + t) * 136 + k] = f2bf(kin[i] * __expf(be3 + base));
    }
    }
    __syncthreads();
    for (int tile = w; tile < 4 * nsb; tile += 8) {
        const int ti = tile >> 2, tj = tile & 3;
        f32x4 acc = (f32x4){0.f, 0.f, 0.f, 0.f};
        if (tj <= ti) {
            const int kb = 8 * ti * (ti + 1);
#pragma unroll
            for (int kk = 0; kk < 4; ++kk) {
                const bf16x8 a = *(const LAS bf16x8*)(Qp + (16 * ti + fr) * 136 + 32 * kk + 8 * fq), bb = *(const LAS bf16x8*)(Kp + (kb + 16 * tj + fr) * 136 + 32 * kk + 8 * fq);
                acc = __builtin_amdgcn_mfma_f32_16x16x32_bf16(a, bb, acc, 0, 0, 0);
            }
            const int lim = (tj == ti) ? 4 * fq : 64;
#pragma unroll
            for (int r = 0; r < 4; ++r) acc[r] = (fr > lim + r) ? 0.f : acc[r];
        }
#pragma unroll
        for (int r = 0; r < 4; ++r) Ps[(16 * ti + 4 * fq + r) * 72 + 16 * tj + fr] = f2bf(acc[r]);
    }
    __syncthreads();
    const bf16_t* ST = (const bf16_t*)(p.ws + WS_S) + (size_t)uid * 16384;
    bf16x8 sf[4];
#pragma unroll
    for (int kk = 0; kk < 4; ++kk) sf[kk] = *(const bf16x8*)(ST + (16 * w + fr) * 128 + 32 * kk + 8 * fq);
    const bf16x8 vf0 = gather8(Vs + (8 * fq) * 130 + 16 * w + fr, 130), vf1 = gather8(Vs + (32 + 8 * fq) * 130 + 16 * w + fr, 130);
    f32x4 o[4];
#pragma unroll
    for (int tt = 0; tt < 4; ++tt) {
        f32x4 acc = (f32x4){0.f, 0.f, 0.f, 0.f};
        if (tt < nsb) {
#pragma unroll
        for (int kk = 0; kk < 4; ++kk) { const bf16x8 a = *(const LAS bf16x8*)(Qt + (16 * tt + fr) * 136 + 32 * kk + 8 * fq); acc = __builtin_amdgcn_mfma_f32_16x16x32_bf16(sf[kk], a, acc, 0, 0, 0); }
        { const bf16x8 a = *(const LAS bf16x8*)(Ps + (16 * tt + fr) * 72 + 8 * fq); acc = __builtin_amdgcn_mfma_f32_16x16x32_bf16(vf0, a, acc, 0, 0, 0); }
        { const bf16x8 a = *(const LAS bf16x8*)(Ps + (16 * tt + fr) * 72 + 32 + 8 * fq); acc = __builtin_amdgcn_mfma_f32_16x16x32_bf16(vf1, a, acc, 0, 0, 0); }
        o[tt] = acc;
        float sq = (acc[0] * acc[0] + acc[1] * acc[1]) + (acc[2] * acc[2] + acc[3] * acc[3]);
        sq += __shfl_xor(sq, 16); sq += __shfl_xor(sq, 32);
        if (fq == 0) SS[w * 64 + 16 * tt + fr] = sq;
        }
    }
    const int v0 = 16 * w + 4 * fq; const f32x4 gain = *(const f32x4*)(p.in[15] + (j * 4 + h) * 128 + v0);
    u32x2 graw[4];
#pragma unroll
    for (int tt = 0; tt < 4; ++tt) { const int t = 16 * tt + fr; const int tc = t < ntok ? t : ntok - 1;
        graw[tt] = *(const u32x2*)(QKV + (size_t)(row0 + tc) * QKVW + 2304 + h * 128 + v0); }
    __syncthreads();
#pragma unroll
    for (int tt = 0; tt < 4; ++tt) if (tt < nsb) { const int t = 16 * tt + fr;
        float tot = 0.f;
#pragma unroll
        for (int ww = 0; ww < 8; ++ww) tot += SS[ww * 64 + t];
        const float rs = __builtin_amdgcn_rsqf(tot * (1.0f / 128.0f) + EPS);
        const f32x4 gt = (f32x4){lo_bf(graw[tt].x), hi_bf(graw[tt].x), lo_bf(graw[tt].y), hi_bf(graw[tt].y)};
        const f32x4 r4 = o[tt] * gain * gt * rs;
        u32x2 ow; ow.x = pk2(r4[0], r4[1]); ow.y = pk2(r4[2], r4[3]);
        if (t < ntok) *(u32x2*)(CAT + (size_t)(row0 + t) * DM + 512 + h * 128 + v0) = ow;
    }
}

template <class Sched> __device__ __forceinline__ void load_rstd_table(const P& p, const Sched& S, LAS unsigned char* lds) {
    const int tid = otid(); LAS float* T = (LAS float*)(lds + LDS_RSTD); const float* R = (const float*)(p.ws + WS_RSTD);
    pg8::Unit u;
    for (int i = 0; i < 7; ++i) { if (!S.next(i, u)) break; if (tid < 256) T[i * 256 + tid] = R[u.pm * 256 + tid]; }
    __syncthreads();
}

#define XB_TMO      128
#define XB_XCNT(j)  (256  + 64 * (j))
#define XB_XSUB(j)  (1280 + 64 * (j))
#define XB_XGEN(j)  (2304 + 64 * (j))
#define XB_TOP      3328
#define XB_TOPGEN   3392
#define XCD_BAR_WORDS 3456
#define XB_SPIN_CAP (1u << 18)
__device__ __forceinline__ unsigned xb_ld(unsigned* p)              { return __hip_atomic_load(p, __ATOMIC_RELAXED, __HIP_MEMORY_SCOPE_AGENT); }
__device__ __forceinline__ unsigned xb_add(unsigned* p, unsigned v) { return __hip_atomic_fetch_add(p, v, __ATOMIC_RELAXED, __HIP_MEMORY_SCOPE_AGENT); }
__device__ __forceinline__ unsigned xb_xcc_id() { return (unsigned)__builtin_amdgcn_s_getreg((3 << 11) | 20) & 0xFu; }
#define XB_SPIN(cond, bar) do { unsigned _sp = 0; while (cond) { __builtin_amdgcn_s_sleep(1); \
    if ((++_sp & 255u) == 0u) { if (xb_ld(&(bar)[XB_TMO])) break; if (_sp > XB_SPIN_CAP) { atomicAdd(&(bar)[XB_TMO], 1u); break; } } } } while (0)
struct XcdBarrier { unsigned* bar; unsigned x; volatile LAS unsigned* st; };
__device__ __forceinline__ XcdBarrier xcd_barrier_post(unsigned* bar, volatile LAS unsigned* st) {
    XcdBarrier b; b.bar = bar; b.x = xb_xcc_id(); b.st = st;
    if (threadIdx.x == 0) (void)xb_add(&bar[XB_XCNT(b.x)], 1u);
    return b;
}
__device__ __forceinline__ void xcd_barrier_complete(unsigned* bar, unsigned x, unsigned& nloc, unsigned& nx) {
    const unsigned G = gridDim.x * gridDim.y * gridDim.z;
    unsigned sum, cnt, mine, sp = 0u;
    for (;;) {
        sum = 0u; cnt = 0u; mine = 0u;
#pragma unroll
        for (unsigned j = 0; j < 16; ++j) { const unsigned c = xb_ld(&bar[XB_XCNT(j)]); sum += c; cnt += (c > 0u) ? 1u : 0u; mine = (j == x) ? c : mine; }
        if (sum == G) break;
        __builtin_amdgcn_s_sleep(1);
        if ((++sp & 255u) == 0u) { if (xb_ld(&bar[XB_TMO])) break; if (sp > XB_SPIN_CAP) { atomicAdd(&bar[XB_TMO], 1u); break; } }
    }
    nloc = mine > 0u ? mine : 1u; nx = cnt > 0u ? cnt : 1u;
}
__device__ __forceinline__ void xcd_barrier(const XcdBarrier& b) {
    asm volatile("s_waitcnt vmcnt(0)" ::: "memory");
    __syncthreads();
    if (threadIdx.x == 0) {
        unsigned* bar = b.bar;
        __builtin_amdgcn_s_waitcnt(0);
        unsigned nloc = b.st[0], nx = b.st[1];
        if (nloc == 0u) { xcd_barrier_complete(bar, b.x, nloc, nx); b.st[0] = nloc; b.st[1] = nx; }
        const unsigned old = xb_add(&bar[XB_XSUB(b.x)], 1u);
        const unsigned gen = old / nloc;
        if (old + 1u == (gen + 1u) * nloc) {
            __builtin_amdgcn_fence(__ATOMIC_RELEASE, "agent");
            asm volatile("s_waitcnt vmcnt(0)" ::: "memory");
            const unsigned og = xb_add(&bar[XB_TOP], 1u);
            const unsigned tg = og / nx;
            if (og + 1u == (tg + 1u) * nx) xb_add(&bar[XB_TOPGEN], 1u);
            else XB_SPIN(xb_ld(&bar[XB_TOPGEN]) == tg, bar);
            __builtin_amdgcn_fence(__ATOMIC_ACQUIRE, "agent");
            xb_add(&bar[XB_XGEN(b.x)], 1u);
            asm volatile("s_waitcnt vmcnt(0)" ::: "memory");
        } else {
            XB_SPIN(xb_ld(&bar[XB_XGEN(b.x)]) == gen, bar);
            __builtin_amdgcn_fence(__ATOMIC_ACQUIRE, "agent");
            asm volatile("s_waitcnt vmcnt(0)" ::: "memory");
        }
    }
    __syncthreads();
}

__global__ void __launch_bounds__(512, 2) mega(P p) {
    extern __shared__ __attribute__((aligned(16))) unsigned char shm[];
    LAS unsigned char* lds = (LAS unsigned char*)shm;
    cg::grid_group grid = cg::this_grid();
    if (threadIdx.x == 0) { ((volatile LAS unsigned*)(lds + LDS_MAIN))[0] = 0u; ((volatile LAS unsigned*)(lds + LDS_MAIN))[1] = 0u; }
    __syncthreads();
    const XcdBarrier bar = xcd_barrier_post((unsigned*)(p.ws + WS_CTL), (volatile LAS unsigned*)(lds + LDS_MAIN));
#define GRID_SYNC() do { xcd_barrier(bar); if (PROBE_DUP == 4) xcd_barrier(bar); } while (0)
    const int G = gridDim.x; int bid = blockIdx.x;
    unsigned my_rank = 0u, my_xcc = 0u;
    if (threadIdx.x == 0) { my_xcc = xb_xcc_id(); my_rank = xb_add((unsigned*)(p.ws + WS_CTL) + 8 * my_xcc, 1u); }
    const float* gains = p.in[7];
    bf16_t* H = (bf16_t*)(p.ws + WS_H); bf16_t* ACT = (bf16_t*)(p.ws + WS_ACT); bf16_t* CAT = (bf16_t*)(p.ws + WS_CAT);
    const bf16_t* XR = (const bf16_t*)(p.ws + WS_X);

    if (bid == 0) { for (int i = otid(); i < 1024; i += 512) ((float*)(p.ws + WS_LB))[i] = hgrn_lb(p, i >> 9, i & 511); }
    convert_weights(p, 0, lds, 0, 1 << 30, bid, G);
    norm_phase<0, 0>(p, nullptr, gains, 0.f);
    if (p.out == nullptr) grid.sync();
    GRID_SYNC();
    if (threadIdx.x == 0) { bool ok = (G == 256);
        for (unsigned x = 0; x < 16; ++x) ok = ok && (xb_ld((unsigned*)(p.ws + WS_CTL) + 8 * x) == (x < 8 ? 32u : 0u));
        ((volatile LAS unsigned*)(lds + LDS_MAIN))[4] = ok ? (my_rank * 8u + my_xcc) : (unsigned)blockIdx.x; }
    __syncthreads();
    bid = __builtin_amdgcn_readfirstlane((int)((volatile LAS unsigned*)(lds + LDS_MAIN))[4]);
    for (int step = 0; step < 12; ++step) {
        const int l = step / 3, kind = step - l * 3, j = l >> 1;
        const float* gl = gains + (size_t)l * 6 * DM;
        unsigned char* wb = p.ws + WS_W + (size_t)(l & 1) * W_END;
        const int ca1 = 3360, ca2 = ca1 + ((l & 1) ? 4992 : 1344), ca3 = ca2 + 3360;
        if (kind != 1) {
            const int which = kind >> 1;
            { pg8::Gemm g{XR, (const bf16_t*)(wb + (which ? W_GUB : W_GUA)), ROWS_PAD, 5632, 1024}; pg8::StaticOrder S; S.init(ROWS_PAD, 5632, 1024, G, bid); load_rstd_table(p, S, lds);
              EpiSwiglu E{ACT, FF}; pg8::gemm_phase(lds, g, S, E);
              if (l < 3 && bid >= 172) convert_weights(p, l + 1, lds, which ? ca2 : 0, which ? ca3 : ca1, bid - 172, G - 172);
              if (PROBE_DUP == 1) { GRID_SYNC(); pg8::gemm_phase(lds, g, S, E); } }
            GRID_SYNC();
            { pg8::Gemm g{ACT, (const bf16_t*)(wb + (which ? W_DB : W_DA)), ROWS_PAD, 1024, FF}; pg8::TailOrder S; S.init(FF, G, bid, PNT_D);
              EpiPlainTail E{H, (float*)(p.ws + WS_U)}; pg8::gemm_phase(lds, g, S, E);
              if (PROBE_DUP == 2) { GRID_SYNC(); pg8::gemm_phase(lds, g, S, E); } }
            GRID_SYNC();
            if (which == 0) norm_phase<1, 44 / PNT_D>(p, gl + 1 * DM, gl + 2 * DM, 0.5f);
            else if (l < 3) { norm_phase<1, 44 / PNT_D>(p, gl + 5 * DM, gl + 6 * DM, 0.5f); convert_weights(p, l + 1, lds, ca3, 1 << 30, bid, G); }
            else norm_phase<2, 44 / PNT_D>(p, gl + 5 * DM, nullptr, 0.5f);
            if (step != 11) GRID_SYNC();
        } else {
            if ((l & 1) == 0) {
                { pg8::Gemm g{XR, (const bf16_t*)(wb + W_IN), ROWS_PAD, 2816, 1024}; pg8::StaticOrder S; S.init(ROWS_PAD, 2816, 1024, G, bid); load_rstd_table(p, S, lds);
                  EpiEvenIn E{ACT, (const float*)(p.ws + WS_LB) + j * 512}; pg8::gemm_phase(lds, g, S, E);
                  if (l < 3 && bid >= 214) convert_weights(p, l + 1, lds, ca1, ca2, bid - 214, G - 214);
                  if (PROBE_DUP == 5) { GRID_SYNC(); pg8::gemm_phase(lds, g, S, E); } }
                GRID_SYNC();
                for (int rep = 0; rep < (PROBE_DUP == 3 ? 2 : 1); ++rep) {
                for (int r2 = 0; r2 < (PROBE_DUP == 6 || PROBE_DUP == 9 ? 2 : 1); ++r2) {
                for (int it = bid; it < 1072; it += G) h1_item(p, j, it, lds);
                GRID_SYNC(); }
                for (int r2 = 0; r2 < (PROBE_DUP == 7 ? 2 : 1); ++r2) {
                h2_phase(p, j);
                GRID_SYNC(); }
                for (int r2 = 0; r2 < (PROBE_DUP == 8 ? 2 : 1); ++r2) {
                for (int it = bid; it < 1072 + 536; it += G) { if (it < 1072) h3_item(p, j, it, lds); else att_item(p, j, it - 1072, lds); }
                GRID_SYNC(); }
                }
            } else {
                { pg8::Gemm g{XR, (const bf16_t*)(wb + W_IN), ROWS_PAD, 3072, 1024}; pg8::StaticOrder S; S.init(ROWS_PAD, 3072, 1024, G, bid); load_rstd_table(p, S, lds);
                  EpiOddIn E{ACT, ACT + (size_t)ROWS_PAD * 1024}; pg8::gemm_phase(lds, g, S, E);
                  if (l < 3 && bid >= 24) convert_weights(p, l + 1, lds, ca1, ca2, bid - 24, G - 24); }
                GRID_SYNC();
                conv_phase(p, j);
                GRID_SYNC();
            }
            { pg8::Gemm g{CAT, (const bf16_t*)(wb + W_OUT), ROWS_PAD, 1024, 1024}; pg8::TailOrder S; S.init(1024, G, bid, PNT_O);
              EpiPlainTail E{H, (float*)(p.ws + WS_U)}; pg8::gemm_phase(lds, g, S, E); }
            GRID_SYNC();
            norm_phase<1, 16 / PNT_O>(p, gl + 3 * DM, gl + 4 * DM, 1.0f);
            GRID_SYNC();
        }
    }
}

extern "C" void kernel_launch(void* const* d_in, const int* in_sizes, int n_in, void* d_out, int out_size, void* d_ws, size_t ws_size, hipStream_t stream) {
    static int grid_blocks = 0;
    if (grid_blocks == 0) {
        if (n_in != 19 || ws_size < WS_END) { fprintf(stderr, "kernel_launch: need 19 inputs and %zu bytes of workspace (got %d, %zu)\n", (size_t)WS_END, n_in, ws_size); grid_blocks = -1; return; }
        int dev = 0, cus = 0, per_cu = 0;
        hipGetDevice(&dev);
        hipDeviceGetAttribute(&cus, hipDeviceAttributeMultiprocessorCount, dev);
        if (hipFuncSetAttribute((const void*)mega, hipFuncAttributeMaxDynamicSharedMemorySize, LDS_BYTES) != hipSuccess) { fprintf(stderr, "kernel_launch: hipFuncSetAttribute failed\n"); grid_blocks = -1; return; }
        hipOccupancyMaxActiveBlocksPerMultiprocessor(&per_cu, (const void*)mega, 512, LDS_BYTES);
        if (per_cu < 1) { fprintf(stderr, "kernel_launch: occupancy query says %d blocks per CU\n", per_cu); per_cu = 1; }
        (void)hipGetLastError();
        grid_blocks = cus * 1;
        if (grid_blocks != 256) { fprintf(stderr, "kernel_launch: built for a 256-CU device (got %d CUs); nothing launched\n", cus); grid_blocks = -1; return; }
    }
    if (grid_blocks < 0) return;
    if (hipMemsetAsync((char*)d_ws + WS_CTL, 0, CTL_BYTES, stream) != hipSuccess) { fprintf(stderr, "kernel_launch: memset of barrier words failed\n"); return; }
    P p{};
    for (int i = 0; i < 19; ++i) p.in[i] = (const float*)d_in[i];
    p.out = (float*)d_out; p.ws = (unsigned char*)d_ws;
    void* args[] = {&p};
    hipError_t e = hipLaunchCooperativeKernel((const void*)mega, dim3(grid_blocks), dim3(512), args, LDS_BYTES, stream);
    if (e != hipSuccess) fprintf(stderr, "cooperative launch failed: %s (grid %d)\n", hipGetErrorString(e), grid_blocks);
}
```
